# Optimizing an MI355X kernel written in HIP

```python
import jax, jax.numpy as jnp
from jax import lax
import numpy as np

D_MODEL = 1024
BATCH = 8
SEQ = 8192
DEPTH = 1
DEC_BATCH = 8
DEC_SEQ = 2048
PAST_LEN = 128

GRID_W = 64
POOL_WIDTH = D_MODEL // 2
POOL_GROUPS = 4
POOL_GROUP_W = POOL_WIDTH // POOL_GROUPS
POOL_WINDOWS = (2, 4, 8, 16)
NA_HEADS = 8
NA_HEAD_DIM = 64
NA_WIDTH = NA_HEADS * NA_HEAD_DIM
NA_ROWS_MAX = 8
NA_COLS = 16
NA_KEY_COLS = 2 * NA_COLS
N_COL_BLOCKS = GRID_W // NA_COLS
D_FF = 4 * D_MODEL
N_BRANCH = 2
IN_WIDTH = POOL_WIDTH + 3 * NA_WIDTH + N_BRANCH * D_MODEL
RMS_EPS = 1e-6
NEG_INF = -1e30

kernel_name = "hybrid_pool_natten_encoder"


def _rmsnorm(x, g):
    xf = x.astype(jnp.float32)
    var = jnp.mean(xf * xf, axis=-1, keepdims=True)
    return (xf * lax.rsqrt(var + RMS_EPS) * g.astype(jnp.float32)).astype(x.dtype)


def _multiscale_pool(p, w_grp, scale):
    b, s, _ = p.shape
    pf = p.astype(jnp.float32)
    csum = jnp.concatenate([jnp.zeros((b, 1, POOL_WIDTH), jnp.float32), jnp.cumsum(pf, axis=1)], axis=1)
    t = np.arange(s)
    outs = []
    for g, w in enumerate(POOL_WINDOWS):
        lo = np.clip(t - w // 2, 0, s)
        hi = np.clip(t + w // 2, 0, s)
        cnt = jnp.asarray(hi - lo, jnp.float32)[None, :, None]
        sl = slice(g * POOL_GROUP_W, (g + 1) * POOL_GROUP_W)
        cg = csum[..., sl]
        mean = (jnp.take(cg, jnp.asarray(hi), axis=1) - jnp.take(cg, jnp.asarray(lo), axis=1)) / cnt
        outs.append(mean - pf[..., sl])
    pooled = jnp.stack(outs, axis=2).astype(p.dtype)
    mixed = jnp.einsum('bsgc,gcd->bsgd', pooled, w_grp).reshape(b, s, POOL_WIDTH)
    return mixed * scale


def _na_tables(rows):
    kr = min(NA_ROWS_MAX, rows)
    r = np.arange(rows)
    rs = np.clip(r - kr // 2, 0, rows - kr)
    row_idx = rs[:, None] + np.arange(kr)[None, :]
    dr = row_idx - r[:, None]
    c0 = np.arange(N_COL_BLOCKS) * NA_COLS
    kcs = np.clip(c0 - NA_COLS // 2, 0, GRID_W - NA_KEY_COLS)
    col_idx = kcs[:, None] + np.arange(NA_KEY_COLS)[None, :]
    qcol = c0[:, None] + np.arange(NA_COLS)[None, :]
    cs = np.clip(qcol - NA_COLS // 2, 0, GRID_W - NA_COLS)
    kc = col_idx[:, None, :]
    dc = kc - qcol[:, :, None]
    col_valid = (kc >= cs[..., None]) & (kc < cs[..., None] + NA_COLS)
    return kr, row_idx, dr, col_idx, dc, col_valid


def _neighbourhood_attention(q, k, v, rpb):
    b, s, _ = q.shape
    rows = s // GRID_W
    kr, row_idx, dr, col_idx, dc, col_valid = _na_tables(rows)
    dr_i = jnp.asarray(dr + NA_ROWS_MAX - 1)[:, None, None, :, None]
    dc_i = jnp.asarray(np.clip(dc + NA_COLS - 1, 0, 2 * NA_COLS - 2))[None, :, :, None, :]
    bias = rpb.astype(jnp.float32)[:, dr_i, dc_i]
    bias = jnp.where(jnp.asarray(col_valid)[None, None, :, :, None, :], bias, NEG_INF)
    row_idx_j = jnp.asarray(row_idx)
    col_idx_j = jnp.asarray(col_idx)
    scale = NA_HEAD_DIM ** -0.5
    grid = (b, rows, GRID_W, NA_HEADS, NA_HEAD_DIM)

    def one(args):
        qe, ke, ve = args
        qb = qe.reshape(rows, N_COL_BLOCKS, NA_COLS, NA_HEADS, NA_HEAD_DIM)
        kb = ke[row_idx_j][:, :, col_idx_j]
        vb = ve[row_idx_j][:, :, col_idx_j]
        sc = jnp.einsum('rnqhd,rinjhd->hrnqij', qb, kb,
                        preferred_element_type=jnp.float32) * scale + bias
        sh = sc.shape
        pr = jax.nn.softmax(sc.reshape(sh[:4] + (kr * NA_KEY_COLS,)), axis=-1).reshape(sh)
        o = jnp.einsum('hrnqij,rinjhd->rnqhd', pr.astype(ve.dtype), vb)
        return o.reshape(s, NA_WIDTH)

    return lax.map(one, (q.reshape(grid), k.reshape(grid), v.reshape(grid)))


def _layer(x, norm_mix, w_in, b_gate, w_pool_grp, pool_scale, w_pool_proj, rpb,
           w_na_proj, w_out, norm_mlp, w_ff1, w_ff2):
    xn = _rmsnorm(x, norm_mix)
    z = xn @ w_in
    o1 = POOL_WIDTH
    o2 = o1 + NA_WIDTH
    o3 = o2 + NA_WIDTH
    o4 = o3 + NA_WIDTH
    p, q, k, v, g = z[..., :o1], z[..., o1:o2], z[..., o2:o3], z[..., o3:o4], z[..., o4:]
    gates = jax.nn.sigmoid(g + b_gate)
    g_pool, g_na = gates[..., :D_MODEL], gates[..., D_MODEL:]
    pool_out = _multiscale_pool(p, w_pool_grp, pool_scale) @ w_pool_proj
    na_out = _neighbourhood_attention(q, k, v, rpb) @ w_na_proj
    x = x + (g_pool * pool_out + g_na * na_out) @ w_out
    xn = _rmsnorm(x, norm_mlp)
    hid = jnp.square(jax.nn.relu(xn @ w_ff1))
    return x + hid @ w_ff2


def _trunk(x, norm_mix, w_in, b_gate, w_pool_grp, pool_scale, w_pool_proj, rpb,
           w_na_proj, w_out, norm_mlp, w_ff1, w_ff2, norm_final):
    for l in range(DEPTH):
        x = _layer(x, norm_mix[l], w_in[l], b_gate[l], w_pool_grp[l], pool_scale[l],
                   w_pool_proj[l], rpb[l], w_na_proj[l], w_out[l], norm_mlp[l],
                   w_ff1[l], w_ff2[l])
    return _rmsnorm(x, norm_final)


def setup_inputs(seed: int = 0) -> dict:
    key = jax.random.key(seed)
    ks = jax.random.split(key, 16)
    f32 = jnp.float32
    nrm = lambda k, shape, s: jax.random.normal(k, shape, f32) * s
    return {
        "x_prompt": nrm(ks[0], (BATCH, SEQ, D_MODEL), 1.0),
        "x_sample": nrm(ks[1], (DEC_BATCH, DEC_SEQ, D_MODEL), 1.0),
        "norm_mix": 1.0 + nrm(ks[2], (DEPTH, D_MODEL), 0.02),
        "w_in": nrm(ks[3], (DEPTH, D_MODEL, IN_WIDTH), D_MODEL ** -0.5),
        "b_gate": nrm(ks[4], (DEPTH, N_BRANCH * D_MODEL), 0.1),
        "w_pool_grp": nrm(ks[5], (DEPTH, POOL_GROUPS, POOL_GROUP_W, POOL_GROUP_W), POOL_GROUP_W ** -0.5),
        "pool_scale": 1.0 + nrm(ks[6], (DEPTH, POOL_WIDTH), 0.02),
        "w_pool_proj": nrm(ks[7], (DEPTH, POOL_WIDTH, D_MODEL), POOL_WIDTH ** -0.5),
        "rpb": nrm(ks[8], (DEPTH, NA_HEADS, 2 * NA_ROWS_MAX - 1, 2 * NA_COLS - 1), 0.1),
        "w_na_proj": nrm(ks[9], (DEPTH, NA_WIDTH, D_MODEL), NA_WIDTH ** -0.5),
        "w_out": nrm(ks[10], (DEPTH, D_MODEL, D_MODEL), D_MODEL ** -0.5),
        "norm_mlp": 1.0 + nrm(ks[11], (DEPTH, D_MODEL), 0.02),
        "w_ff1": nrm(ks[12], (DEPTH, D_MODEL, D_FF), D_MODEL ** -0.5),
        "w_ff2": nrm(ks[13], (DEPTH, D_FF, D_MODEL), D_FF ** -0.5),
        "norm_final": 1.0 + nrm(ks[14], (D_MODEL,), 0.02),
    }


def reference(x_prompt, x_sample, norm_mix, w_in, b_gate, w_pool_grp, pool_scale, w_pool_proj,
              rpb, w_na_proj, w_out, norm_mlp, w_ff1, w_ff2, norm_final):
    y_prompt = _trunk(x_prompt, norm_mix, w_in, b_gate, w_pool_grp, pool_scale, w_pool_proj, rpb,
                      w_na_proj, w_out, norm_mlp, w_ff1, w_ff2, norm_final)
    y_sample = _trunk(x_sample, norm_mix, w_in, b_gate, w_pool_grp, pool_scale, w_pool_proj, rpb,
                      w_na_proj, w_out, norm_mlp, w_ff1, w_ff2, norm_final)
    return (y_prompt, y_sample)
```

```cpp
#include <hip/hip_runtime.h>
#include <hip/hip_cooperative_groups.h>
#include <cstdio>
#include <cstdint>
namespace cg = cooperative_groups;
namespace pg8 {
#define PG8_LAS __attribute__((address_space(3)))
typedef unsigned short bf16_t;
typedef short bf16x8 __attribute__((ext_vector_type(8)));
typedef float f32x4 __attribute__((ext_vector_type(4)));
typedef unsigned u32x4 __attribute__((ext_vector_type(4)));
constexpr int BM = 256, BK = 64, HALF = 128, HTB = HALF * BK * 2  , STAGE_BYTES = 8 * HTB, NXCD = 8, WGM = 8;

__host__ __device__ __forceinline__ int lds_byte(int r, int c) { const int st = (r >> 4) * 2 + (c >> 5), rr = r & 15, cc = c & 31, ob = rr * 64 + cc * 2; return st * 1024 + (ob ^ (((ob >> 9) & 1) << 5)); }
__host__ __device__ __forceinline__ void stage_rc(int b, int& R, int& C) { const int st = b / 1024, sb = b % 1024, swz = sb ^ (((sb >> 9) & 1) << 5); R = (st >> 1) * 16 + swz / 64; C = (st & 1) * 32 + (swz % 64) / 2; }
__host__ __device__ __forceinline__ int perm32(int rho) { const int n = rho >> 4, i = rho & 15; return 8 * (i >> 2) + 4 * n + (i & 3); }

struct Unit { int pm, pn; };
struct Gemm { const bf16_t* A; const bf16_t* Bt; int M, N, K; };

struct StaticOrder {
    int nM, nN, nwg, G, c;
    __host__ __device__ void init(int M, int N, int G_, int c_) { nM = M / BM; nN = N / BM; nwg = nM * nN; G = G_; c = c_; }
    __host__ __device__ bool next(int i, Unit& u) const {
        const long L = (long)i * G + c; if (L >= nwg) return false;
        int wgid = (int)L; { const int q = nwg / NXCD, r = nwg % NXCD, xcd = wgid % NXCD, off = wgid / NXCD; wgid = (xcd < r ? xcd * (q + 1) : r * (q + 1) + (xcd - r) * q) + off; }
        const int nig = WGM * nN, gid = wgid / nig, fm = gid * WGM, gsz = (nM - fm) < WGM ? (nM - fm) : WGM;
        u.pm = fm + ((wgid % nig) % gsz); u.pn = (wgid % nig) / gsz; return true;
    }
    __device__ __forceinline__ void a_ready(const Unit&) const {}
    __device__ __forceinline__ void done(const Unit&) const {}
};

__device__ __forceinline__ unsigned cvt_pk_bf16(float lo, float hi) { unsigned r; asm volatile("v_cvt_pk_bf16_f32 %0, %1, %2" : "=v"(r) : "v"(lo), "v"(hi)); return r; }
typedef float f32x2 __attribute__((ext_vector_type(2)));
__device__ __forceinline__ float bf_lo(unsigned w) { return __uint_as_float(w << 16); }
__device__ __forceinline__ float bf_hi(unsigned w) { return __uint_as_float(w & 0xffff0000u); }
__device__ __forceinline__ float sigmoidf_fast(float x) { return __builtin_amdgcn_rcpf(1.0f + __builtin_amdgcn_exp2f(-1.4426950408889634f * x)); }
__device__ __forceinline__ u32x4 pack8(const f32x4 v0, const f32x4 v1) { u32x4 w; w.x = cvt_pk_bf16(v0[0], v0[1]); w.y = cvt_pk_bf16(v0[2], v0[3]); w.z = cvt_pk_bf16(v1[0], v1[1]); w.w = cvt_pk_bf16(v1[2], v1[3]); return w; }
__device__ __forceinline__ void unpack8(const u32x4 w, f32x4& v0, f32x4& v1) { v0 = (f32x4){bf_lo(w.x), bf_hi(w.x), bf_lo(w.y), bf_hi(w.y)}; v1 = (f32x4){bf_lo(w.z), bf_hi(w.z), bf_lo(w.w), bf_hi(w.w)}; }

struct EpiZ {
    static constexpr bool PERM = true, AFTER_DRAIN = false;
    bf16_t* ZP; bf16_t* GT; const float* bgate;
    __device__ __forceinline__ void operator()(const f32x4 (&acc)[2][2][4][2], const Unit& u, int wr, int wc, int fr, int fq) const {
        const int row0 = u.pm * BM + wr * 64 + fr; const bool gate = u.pn >= 8;
        const int col0 = (u.pn & 7) * BM + wc * 32 + 8 * fq;
        bf16_t* base = gate ? GT : ZP;
        f32x4 bv[2][2];
#pragma unroll
        for (int bj = 0; bj < 2; ++bj)
#pragma unroll
            for (int n = 0; n < 2; ++n) bv[bj][n] = gate ? *(const f32x4*)(bgate + col0 + bj * HALF + 4 * n) : (f32x4){0.f, 0.f, 0.f, 0.f};
#pragma unroll
        for (int ai = 0; ai < 2; ++ai)
#pragma unroll
            for (int m = 0; m < 4; ++m) { bf16_t* rowp = base + (size_t)(row0 + ai * HALF + m * 16) * 2048 + col0;
#pragma unroll
                for (int bj = 0; bj < 2; ++bj) { f32x4 v0 = acc[ai][bj][m][0], v1 = acc[ai][bj][m][1];
                    if (gate) { v0 += bv[bj][0]; v1 += bv[bj][1];
#pragma unroll
                        for (int e = 0; e < 4; ++e) { v0[e] = sigmoidf_fast(v0[e]); v1[e] = sigmoidf_fast(v1[e]); } }
                    *(u32x4*)(rowp + bj * HALF) = pack8(v0, v1); } }
    }
};
template <bool ADD> struct EpiMix {
    static constexpr bool PERM = true, AFTER_DRAIN = false;
    bf16_t* MIX; const bf16_t* GT; int gcol0;
    __device__ __forceinline__ void operator()(const f32x4 (&acc)[2][2][4][2], const Unit& u, int wr, int wc, int fr, int fq) const {
        const int row0 = u.pm * BM + wr * 64 + fr; const int col0 = u.pn * BM + wc * 32 + 8 * fq;
#pragma unroll
        for (int ai = 0; ai < 2; ++ai)
#pragma unroll
            for (int m = 0; m < 4; ++m) { const size_t row = (size_t)(row0 + ai * HALF + m * 16);
#pragma unroll
                for (int bj = 0; bj < 2; ++bj) {
                    const u32x4 gw = *(const u32x4*)(GT + row * 2048 + gcol0 + col0 + bj * HALF);
                    f32x4 g0, g1; unpack8(gw, g0, g1);
                    f32x4 v0 = acc[ai][bj][m][0] * g0, v1 = acc[ai][bj][m][1] * g1;
                    bf16_t* op = MIX + row * 1024 + col0 + bj * HALF;
                    if (ADD) { const u32x4 ow = *(const u32x4*)op; f32x4 o0, o1; unpack8(ow, o0, o1); v0 += o0; v1 += o1; }
                    *(u32x4*)op = pack8(v0, v1); } }
    }
};
template <bool FINAL> struct EpiRes {
    static constexpr bool PERM = true, AFTER_DRAIN = false;
    const float* xa; const float* xb; int msplit;
    float* X1; bf16_t* X1G; const float* gmlp; float* SS;
    __device__ __forceinline__ void operator()(const f32x4 (&acc)[2][2][4][2], const Unit& u, int wr, int wc, int fr, int fq) const {
        const int row0 = u.pm * BM + wr * 64 + fr; const int col0 = u.pn * BM + wc * 32 + 8 * fq;
        const float* xs = (u.pm * BM < msplit) ? xa : xb - (size_t)msplit * 1024;
        f32x4 gv[2][2];
        if (!FINAL) {
#pragma unroll
            for (int bj = 0; bj < 2; ++bj)
#pragma unroll
                for (int n = 0; n < 2; ++n) gv[bj][n] = *(const f32x4*)(gmlp + col0 + bj * HALF + 4 * n);
        }
#pragma unroll
        for (int ai = 0; ai < 2; ++ai)
#pragma unroll
            for (int m = 0; m < 4; ++m) { const size_t row = (size_t)(row0 + ai * HALF + m * 16); float ss = 0.f;
#pragma unroll
                for (int bj = 0; bj < 2; ++bj) { const size_t off = row * 1024 + col0 + bj * HALF;
                    const f32x4 x0 = *(const f32x4*)(xs + off), x1 = *(const f32x4*)(xs + off + 4);
                    const f32x4 v0 = acc[ai][bj][m][0] + x0, v1 = acc[ai][bj][m][1] + x1;
                    *(f32x4*)(X1 + off) = v0; *(f32x4*)(X1 + off + 4) = v1;
                    ss += (v0[0] * v0[0] + v0[1] * v0[1]) + (v0[2] * v0[2] + v0[3] * v0[3]) + (v1[0] * v1[0] + v1[1] * v1[1]) + (v1[2] * v1[2] + v1[3] * v1[3]);
                    if (!FINAL) *(u32x4*)(X1G + off) = pack8(v0 * gv[bj][0], v1 * gv[bj][1]); }
                ss += __shfl_xor(ss, 16); ss += __shfl_xor(ss, 32);
                if (fq == 0) atomicAdd(SS + row, ss); }
    }
};
struct EpiHid {
    static constexpr bool PERM = true, AFTER_DRAIN = false;
    bf16_t* HID; const float* SS; float eps;
    __device__ __forceinline__ void operator()(const f32x4 (&acc)[2][2][4][2], const Unit& u, int wr, int wc, int fr, int fq) const {
        const int row0 = u.pm * BM + wr * 64 + fr; const int col0 = u.pn * BM + wc * 32 + 8 * fq;
#pragma unroll
        for (int ai = 0; ai < 2; ++ai)
#pragma unroll
            for (int m = 0; m < 4; ++m) { const size_t row = (size_t)(row0 + ai * HALF + m * 16);
                const float rs = __builtin_amdgcn_rsqf(SS[row] * (1.0f / 1024.0f) + eps);
#pragma unroll
                for (int bj = 0; bj < 2; ++bj) { f32x4 v0 = acc[ai][bj][m][0] * rs, v1 = acc[ai][bj][m][1] * rs;
#pragma unroll
                    for (int e = 0; e < 4; ++e) { const float a = fmaxf(v0[e], 0.f), b = fmaxf(v1[e], 0.f); v0[e] = a * a; v1[e] = b * b; }
                    *(u32x4*)(HID + row * 4096 + col0 + bj * HALF) = pack8(v0, v1); } }
    }
};

template <class Epi, class Sched, bool ALIGN_EPI = false, bool SP2 = false>
__device__ __forceinline__ void gemm_phase(PG8_LAS unsigned char* lds, const Gemm g, const Sched& S, const Epi& E) {
    const int tid = threadIdx.x, wid = __builtin_amdgcn_readfirstlane(tid >> 6), lane = tid & 63, wr = wid >> 2, wc = wid & 3, fr = lane & 15, fq = lane >> 4;
    const int K = g.K, nt = K / BK;
    unsigned voffA[2], voffB[2];
#pragma unroll
    for (int i = 0; i < 2; ++i) { int R, C; stage_rc(tid * 16 + i * 8192, R, C); const int Rb = Epi::PERM ? ((R & ~31) + perm32(R & 31)) : R;
        voffA[i] = (unsigned)(R * K + C) * 2u; voffB[i] = (unsigned)(Rb * K + C) * 2u; }
    const size_t kstep = (size_t)(BK * 2);
    const size_t hstep = (size_t)HALF * K * 2;
    const size_t tstep = 2 * hstep;
    const unsigned ldsw = (unsigned)wid * 1024u;
    const int aoff = lds_byte(wr * 64 + fr, fq * 8), boff = lds_byte(wc * 32 + fr, fq * 8);
#define PG8_SA(b, h) (((b) * 2 + (h)) * HTB)
#define PG8_SB(b, h) ((4 + (b) * 2 + (h)) * HTB)
#define PG8_STAGE(bufoff, gbase, voff) do { _Pragma("unroll") for (int _i = 0; _i < 2; ++_i) \
        __builtin_amdgcn_global_load_lds((const unsigned*)((const char*)(gbase) + (voff)[_i]), (PG8_LAS unsigned*)(lds + (bufoff) + ldsw + _i * 8192), 16, 0, 0); } while (0)
#define PG8_LDA(dst, b, h) do { _Pragma("unroll") for (int m = 0; m < 4; ++m) _Pragma("unroll") for (int k = 0; k < 2; ++k) dst[m][k] = *(const PG8_LAS bf16x8*)(lds + PG8_SA(b, h) + aoff + m * 2048 + k * 1024); } while (0)
#define PG8_LDB(dst, b, h) do { _Pragma("unroll") for (int n = 0; n < 2; ++n) _Pragma("unroll") for (int k = 0; k < 2; ++k) dst[n][k] = *(const PG8_LAS bf16x8*)(lds + PG8_SB(b, h) + boff + n * 2048 + k * 1024); } while (0)
#define PG8_MMA(ai, bj, At, Bt) do { __builtin_amdgcn_s_setprio(1); _Pragma("unroll") for (int m = 0; m < 4; ++m) _Pragma("unroll") for (int n = 0; n < 2; ++n) _Pragma("unroll") for (int k = 0; k < 2; ++k) \
        acc[ai][bj][m][n] = __builtin_amdgcn_mfma_f32_16x16x32_bf16(Bt[n][k], At[m][k], acc[ai][bj][m][n], 0, 0, 0); __builtin_amdgcn_s_setprio(0); } while (0)
#define PG8_WAIT_V(n) asm volatile("s_waitcnt vmcnt(" #n ")" ::: "memory")
#define PG8_WAIT_L(n) asm volatile("s_waitcnt lgkmcnt(" #n ")" ::: "memory")
#define PG8_BAR __builtin_amdgcn_s_barrier()
#define PG8_SCHED __builtin_amdgcn_sched_barrier(0)
    Unit cur, nxt; int ui = 0;
    if (!S.next(0, cur)) return;
    f32x4 acc[2][2][4][2];
#pragma unroll
    for (int a = 0; a < 2; ++a)
#pragma unroll
        for (int b = 0; b < 2; ++b)
#pragma unroll
            for (int m = 0; m < 4; ++m)
#pragma unroll
                for (int n = 0; n < 2; ++n) acc[a][b][m][n] = (f32x4){0.f, 0.f, 0.f, 0.f};
    bf16x8 At[4][2], B0[2][2], B1[2][2];
    const char* cA = (const char*)g.A + (size_t)cur.pm * tstep; const char* cB = (const char*)g.Bt + (size_t)cur.pn * tstep;
    S.a_ready(cur);
    if constexpr (SP2) {
        PG8_STAGE(PG8_SB(0, 0), cB, voffB); PG8_STAGE(PG8_SB(0, 1), cB + hstep, voffB); PG8_STAGE(PG8_SA(0, 0), cA, voffA); PG8_STAGE(PG8_SA(0, 1), cA + hstep, voffA);
        if (wr == 1) PG8_BAR;
        PG8_WAIT_V(2); PG8_BAR;
        PG8_STAGE(PG8_SB(1, 0), cB + kstep, voffB); PG8_STAGE(PG8_SA(1, 0), cA + kstep, voffA); PG8_STAGE(PG8_SB(1, 1), cB + hstep + kstep, voffB);
        PG8_WAIT_V(6); PG8_BAR;
    } else {
        PG8_STAGE(PG8_SB(0, 0), cB, voffB); PG8_STAGE(PG8_SA(0, 0), cA, voffA); PG8_STAGE(PG8_SB(0, 1), cB + hstep, voffB); PG8_STAGE(PG8_SA(0, 1), cA + hstep, voffA);
        if (wr == 1) PG8_BAR;
        PG8_WAIT_V(4); PG8_BAR;
        PG8_STAGE(PG8_SB(1, 0), cB + kstep, voffB); PG8_STAGE(PG8_SA(1, 0), cA + kstep, voffA); PG8_STAGE(PG8_SB(1, 1), cB + hstep + kstep, voffB);
        PG8_WAIT_V(6); PG8_BAR;
    }
    for (;;) {
        const bool has_next = S.next(ui + 1, nxt);
        const char* nA = has_next ? (const char*)g.A + (size_t)nxt.pm * tstep : cA; const char* nB = has_next ? (const char*)g.Bt + (size_t)nxt.pn * tstep : cB;
        for (int t = 0; t < nt; t += 2) {
            const bool last = (t == nt - 2);
            const char* a1 = cA + (size_t)(t + 1) * kstep;
            const char* a2 = last ? nA : cA + (size_t)(t + 2) * kstep; const char* b2 = last ? nB : cB + (size_t)(t + 2) * kstep;
            const char* a3 = a2 + kstep; const char* b3 = b2 + kstep;
            if (last && has_next) S.a_ready(nxt);
            if constexpr (SP2) {
            PG8_LDB(B0, 0, 0); PG8_LDB(B1, 0, 1); PG8_SCHED; PG8_LDA(At, 0, 0); PG8_STAGE(PG8_SA(1, 1), a1 + hstep, voffA);
            PG8_WAIT_V(8); PG8_WAIT_L(0); PG8_BAR; PG8_MMA(0, 0, At, B0); PG8_MMA(0, 1, At, B1); PG8_BAR; PG8_SCHED;
            PG8_LDA(At, 0, 1); PG8_STAGE(PG8_SB(0, 0), b2, voffB); PG8_STAGE(PG8_SB(0, 1), b2 + hstep, voffB); PG8_STAGE(PG8_SA(0, 0), a2, voffA);
            PG8_WAIT_V(8); PG8_WAIT_L(0); PG8_BAR; PG8_MMA(1, 0, At, B0); PG8_MMA(1, 1, At, B1); PG8_BAR; PG8_SCHED;
            PG8_LDB(B0, 1, 0); PG8_LDB(B1, 1, 1); PG8_SCHED; PG8_LDA(At, 1, 0); PG8_STAGE(PG8_SA(0, 1), a2 + hstep, voffA);
            PG8_WAIT_V(8); PG8_WAIT_L(0); PG8_BAR; PG8_MMA(0, 0, At, B0); PG8_MMA(0, 1, At, B1); PG8_BAR; PG8_SCHED;
            PG8_LDA(At, 1, 1); PG8_STAGE(PG8_SB(1, 0), b3, voffB); PG8_STAGE(PG8_SB(1, 1), b3 + hstep, voffB); PG8_STAGE(PG8_SA(1, 0), a3, voffA);
            PG8_WAIT_V(8); PG8_WAIT_L(0); PG8_BAR; PG8_MMA(1, 0, At, B0); PG8_MMA(1, 1, At, B1); PG8_BAR; PG8_SCHED;
            } else {
            PG8_LDB(B0, 0, 0); PG8_SCHED; PG8_LDA(At, 0, 0); PG8_STAGE(PG8_SA(1, 1), a1 + hstep, voffA);
            PG8_WAIT_L(8); PG8_BAR; PG8_WAIT_L(0); PG8_MMA(0, 0, At, B0); PG8_BAR; PG8_SCHED;
            PG8_LDB(B1, 0, 1); PG8_STAGE(PG8_SB(0, 0), b2, voffB);
            PG8_BAR; PG8_WAIT_L(0); PG8_MMA(0, 1, At, B1); PG8_BAR;
            PG8_LDA(At, 0, 1); PG8_STAGE(PG8_SA(0, 0), a2, voffA);
            PG8_BAR; PG8_WAIT_L(0); PG8_MMA(1, 0, At, B0); PG8_BAR; PG8_SCHED;
            PG8_STAGE(PG8_SB(0, 1), b2 + hstep, voffB);
            PG8_WAIT_V(6); PG8_BAR; PG8_MMA(1, 1, At, B1); PG8_BAR;
            PG8_LDB(B0, 1, 0); PG8_SCHED; PG8_LDA(At, 1, 0); PG8_STAGE(PG8_SA(0, 1), a2 + hstep, voffA);
            PG8_WAIT_L(8); PG8_BAR; PG8_WAIT_L(0); PG8_MMA(0, 0, At, B0); PG8_BAR; PG8_SCHED;
            PG8_LDB(B1, 1, 1); PG8_STAGE(PG8_SB(1, 0), b3, voffB);
            PG8_BAR; PG8_WAIT_L(0); PG8_MMA(0, 1, At, B1); PG8_BAR;
            PG8_LDA(At, 1, 1); PG8_STAGE(PG8_SA(1, 0), a3, voffA);
            PG8_BAR; PG8_WAIT_L(0); PG8_MMA(1, 0, At, B0); PG8_BAR; PG8_SCHED;
            PG8_STAGE(PG8_SB(1, 1), b3 + hstep, voffB);
            PG8_WAIT_V(6); PG8_BAR; PG8_MMA(1, 1, At, B1); PG8_BAR;
            }
        }
        if constexpr (ALIGN_EPI) { if (wr == 0) PG8_BAR; }
        if constexpr (!Epi::AFTER_DRAIN) { E(acc, cur, wr, wc, fr, fq); S.done(cur); }
        if (!has_next) break;
#pragma unroll
        for (int a = 0; a < 2; ++a)
#pragma unroll
            for (int b = 0; b < 2; ++b)
#pragma unroll
                for (int m = 0; m < 4; ++m)
#pragma unroll
                    for (int n = 0; n < 2; ++n) acc[a][b][m][n] = (f32x4){0.f, 0.f, 0.f, 0.f};
        cur = nxt; cA = nA; cB = nB; ++ui;
        if constexpr (ALIGN_EPI) { if (wr == 1) PG8_BAR; }
    }
    PG8_WAIT_V(0);
    if constexpr (!ALIGN_EPI) { if (wr == 0) PG8_BAR; }
    PG8_BAR;
    if constexpr (Epi::AFTER_DRAIN) { E.fused(acc, cur, wr, wc, fr, fq, lds, wid, lane); S.done(cur); }
#undef PG8_SA
#undef PG8_SB
#undef PG8_STAGE
#undef PG8_LDA
#undef PG8_LDB
#undef PG8_MMA
#undef PG8_WAIT_V
#undef PG8_WAIT_L
#undef PG8_BAR
#undef PG8_SCHED
}
}

constexpr int D = 1024, MP = 8 * 8192, MS = 8 * 2048, M = MP + MS, FF = 4096, NZ = 4096, PW = 512, NAW = 512;
constexpr float RMS_EPS = 1e-6f;
constexpr size_t MiB = 1u << 20;
constexpr size_t WS_WIN = 0, WS_WPP = 8 * MiB, WS_WNA = 9 * MiB, WS_WOUT = 10 * MiB, WS_WFF1 = 12 * MiB, WS_WFF2 = 20 * MiB;
constexpr size_t WS_SS1 = 28 * MiB, WS_SS2 = 29 * MiB;
constexpr size_t WS_XN = 32 * MiB;
constexpr size_t WS_POOLED = WS_XN, WS_ATTN = WS_XN + (size_t)M * 512 * 2;
constexpr size_t WS_ZP = 192 * MiB;
constexpr size_t WS_GT = 512 * MiB;
constexpr size_t WS_HID = WS_ZP;
constexpr size_t WS_END = 832 * MiB;
static_assert(WS_XN + (size_t)M * 1024 * 2 <= WS_ZP && WS_ZP + (size_t)M * 2048 * 2 <= WS_GT && WS_GT + (size_t)M * 2048 * 2 <= WS_END && WS_HID + (size_t)M * 4096 * 2 <= WS_END, "ws map");

constexpr int NWAVES = 8, LDS_BYTES = 147456;
#define LAS __attribute__((address_space(3)))
typedef unsigned short bf16;
typedef unsigned v4u __attribute__((ext_vector_type(4)));
typedef unsigned v2u __attribute__((ext_vector_type(2)));
typedef float f32x4 __attribute__((ext_vector_type(4)));
typedef short bf16x8 __attribute__((ext_vector_type(8)));
typedef short s16x4 __attribute__((ext_vector_type(4)));
#define LDS_WAIT() asm volatile("s_waitcnt lgkmcnt(0)" ::: "memory")
__device__ __forceinline__ unsigned f2bf(float f) { unsigned u = __builtin_bit_cast(unsigned, f); return (u + 0x7fffu + ((u >> 16) & 1u)) >> 16; }
__device__ __forceinline__ unsigned pk2(float lo, float hi) { return f2bf(lo) | (f2bf(hi) << 16); }
__device__ __forceinline__ float wave_sum(float v) {
#pragma unroll
    for (int o = 1; o < 64; o <<= 1) v += __shfl_xor(v, o);
    return v;
}

struct Args { const float* in[15]; float* out; unsigned char* ws; };

__device__ __forceinline__ void p0_transpose_item(const float* W, int K, int N, bf16* WT, LAS float* scr, int item, int lane) {
    const int nblk = N / 32, kb = item / nblk, nb = item % nblk, k0 = 64 * kb, n0 = 32 * nb;
#pragma unroll 8
    for (int i = 0; i < 32; ++i) { const int kk = 2 * i + (lane >> 5); scr[kk * 33 + (lane & 31)] = W[(size_t)(k0 + kk) * N + n0 + (lane & 31)]; }
    LDS_WAIT(); asm volatile("" ::: "memory");
    const int c = lane & 7;
#pragma unroll
    for (int j = 0; j < 4; ++j) { const int n = (lane >> 3) + 8 * j; const LAS float* s = scr + (8 * c) * 33 + n;
        v4u o; o.x = pk2(s[0 * 33], s[1 * 33]); o.y = pk2(s[2 * 33], s[3 * 33]); o.z = pk2(s[4 * 33], s[5 * 33]); o.w = pk2(s[6 * 33], s[7 * 33]);
        *(v4u*)(WT + (size_t)(n0 + n) * K + k0 + 8 * c) = o; }
    LDS_WAIT(); asm volatile("" ::: "memory");
}

__device__ __forceinline__ void p0_prologue(const Args& a, LAS unsigned char* lds, int gw, int NGW, int wave, int lane) {
    unsigned char* ws = a.ws;
    LAS float* scr = (LAS float*)(lds + wave * 16384);
    constexpr int I_IN = (D / 64) * (NZ / 32), I_NA = (NAW / 64) * (D / 32), I_OUT = (D / 64) * (D / 32), I_F1 = (D / 64) * (FF / 32), I_F2 = (FF / 64) * (D / 32);
    constexpr int NITEMS = I_IN + I_NA + I_OUT + I_F1 + I_F2;
    for (int it = gw; it < NITEMS; it += NGW) {
        int r = it;
        if (r < I_IN) { p0_transpose_item(a.in[3], D, NZ, (bf16*)(ws + WS_WIN), scr, r, lane); continue; } r -= I_IN;
        if (r < I_NA) { p0_transpose_item(a.in[9], NAW, D, (bf16*)(ws + WS_WNA), scr, r, lane); continue; } r -= I_NA;
        if (r < I_OUT) { p0_transpose_item(a.in[10], D, D, (bf16*)(ws + WS_WOUT), scr, r, lane); continue; } r -= I_OUT;
        if (r < I_F1) { p0_transpose_item(a.in[12], D, FF, (bf16*)(ws + WS_WFF1), scr, r, lane); continue; } r -= I_F1;
        p0_transpose_item(a.in[13], FF, D, (bf16*)(ws + WS_WFF2), scr, r, lane);
    }
    {
        const float* wg = a.in[5]; const float* sc = a.in[6]; const float* wp = a.in[7]; bf16* WPP = (bf16*)(ws + WS_WPP);
        for (int it = NGW - 1 - gw; it < 64 * 16; it += NGW) {
            const int cc = it >> 4, nb = it & 15, g = cc >> 4, c0 = (cc & 15) * 8, n = nb * 64 + lane;
            float acc[8];
#pragma unroll
            for (int j = 0; j < 8; ++j) acc[j] = 0.f;
            for (int d = 0; d < 128; ++d) {
                const float pv = wp[(size_t)(g * 128 + d) * D + n] * sc[g * 128 + d];
#pragma unroll
                for (int j = 0; j < 8; ++j) acc[j] += wg[(size_t)(g * 128 + c0 + j) * 128 + d] * pv;
            }
            v4u o; o.x = pk2(acc[0], acc[1]); o.y = pk2(acc[2], acc[3]); o.z = pk2(acc[4], acc[5]); o.w = pk2(acc[6], acc[7]);
            *(v4u*)(WPP + (size_t)n * PW + g * 128 + c0) = o;
        }
    }
    {
        float* ss1 = (float*)(ws + WS_SS1); float* ss2 = (float*)(ws + WS_SS2);
        for (int i = gw * 64 + lane; i < M; i += NGW * 64) { ss1[i] = 0.f; ss2[i] = 0.f; }
    }
    {
        const float* gm = a.in[2]; bf16* XN = (bf16*)(ws + WS_XN);
        f32x4 gv[4];
#pragma unroll
        for (int j = 0; j < 4; ++j) gv[j] = ((const f32x4*)gm)[lane + 64 * j];
        for (int m = gw; m < M; m += NGW) {
            const float* xrow = (m < MP) ? a.in[0] + (size_t)m * D : a.in[1] + (size_t)(m - MP) * D;
            const f32x4* xr = (const f32x4*)xrow + lane;
            f32x4 v[4]; float s = 0.f;
#pragma unroll
            for (int j = 0; j < 4; ++j) { v[j] = xr[64 * j]; s += (v[j].x * v[j].x + v[j].y * v[j].y) + (v[j].z * v[j].z + v[j].w * v[j].w); }
            const float rstd = 1.0f / sqrtf(wave_sum(s) * (1.f / D) + RMS_EPS);
            unsigned long long* o8 = (unsigned long long*)(XN + (size_t)m * D) + lane;
#pragma unroll
            for (int j = 0; j < 4; ++j) { const f32x4 w = v[j] * rstd * gv[j]; o8[64 * j] = (unsigned long long)pk2(w.x, w.y) | ((unsigned long long)pk2(w.z, w.w) << 32); }
        }
    }
}

__device__ __forceinline__ void p2_pool(const bf16* ZP, bf16* POOLED, int gw, int NGW, int lane) {
    const int half_w = 1 << (lane >> 4);
    const int per = (M + NGW - 1) / NGW;
    const int m0 = gw * per, m1 = (m0 + per < M) ? m0 + per : M;
    for (int m = m0; m < m1; ++m) {
        int t, S; size_t base;
        if (m < MP) { t = m & 8191; S = 8192; base = (size_t)(m - t); } else { const int mm = m - MP; t = mm & 2047; S = 2048; base = (size_t)(m - t); }
        const int lo = (t - half_w > 0) ? t - half_w : 0, hi = (t + half_w < S) ? t + half_w : S;
        float s[8];
#pragma unroll
        for (int e = 0; e < 8; ++e) s[e] = 0.f;
        float self[8];
#pragma unroll
        for (int j = -8; j < 8; ++j) {
            const int tt = t + j;
            if (tt >= lo && tt < hi) {
                const v4u w = *(const v4u*)(ZP + (base + tt) * 2048 + lane * 8);
                s[0] += pg8::bf_lo(w.x); s[1] += pg8::bf_hi(w.x); s[2] += pg8::bf_lo(w.y); s[3] += pg8::bf_hi(w.y);
                s[4] += pg8::bf_lo(w.z); s[5] += pg8::bf_hi(w.z); s[6] += pg8::bf_lo(w.w); s[7] += pg8::bf_hi(w.w);
            }
        }
        { const v4u w = *(const v4u*)(ZP + (size_t)m * 2048 + lane * 8);
          self[0] = pg8::bf_lo(w.x); self[1] = pg8::bf_hi(w.x); self[2] = pg8::bf_lo(w.y); self[3] = pg8::bf_hi(w.y);
          self[4] = pg8::bf_lo(w.z); self[5] = pg8::bf_hi(w.z); self[6] = pg8::bf_lo(w.w); self[7] = pg8::bf_hi(w.w); }
        const float inv = 1.0f / (float)(hi - lo);
        v4u o; o.x = pk2(s[0] * inv - self[0], s[1] * inv - self[1]); o.y = pk2(s[2] * inv - self[2], s[3] * inv - self[3]);
        o.z = pk2(s[4] * inv - self[4], s[5] * inv - self[5]); o.w = pk2(s[6] * inv - self[6], s[7] * inv - self[7]);
        *(v4u*)(POOLED + (size_t)m * PW + lane * 8) = o;
    }
}

constexpr int VSTRIDE = 160;
constexpr int VCHUNK_BYTES = 64 * VSTRIDE;
constexpr int RPB_OFF = 8 * VCHUNK_BYTES;
__device__ __forceinline__ void p2_natten(const bf16* ZP, bf16* ATTN, const float* rpb, LAS unsigned char* lds, int blk, int G, int tid, int wave, int lane) {
    LAS float* rp = (LAS float*)(lds + RPB_OFF);
    for (int i = tid; i < 8 * 15 * 31; i += NWAVES * 64) rp[i] = rpb[i] * 1.4426950408889634f;
    __syncthreads();
    const int h = wave, l15 = lane & 15, g = lane >> 4;
    LAS unsigned char* vs = lds + wave * VCHUNK_BYTES;
    const LAS float* rph = rp + h * 15 * 31;
    constexpr int NUNITS = 8 * 4 * 128 + 8 * 4 * 32;
    const int per = (NUNITS + G - 1) / G;
    const int u0 = blk * per, u1 = (u0 + per < NUNITS) ? u0 + per : NUNITS;
    const float C2 = 0.125f * 1.4426950408889634f;
    for (int u = u0; u < u1; ++u) {
        int seqbase, n, r, rows;
        if (u < 4096) { seqbase = (u >> 9) * 8192; const int rem = u & 511; n = rem >> 7; r = rem & 127; rows = 128; }
        else { const int v = u - 4096; seqbase = MP + (v >> 7) * 2048; const int rem = v & 127; n = rem >> 5; r = rem & 31; rows = 32; }
        int rs = r - 4; rs = rs < 0 ? 0 : rs; rs = rs > rows - 8 ? rows - 8 : rs;
        int kcs = 16 * n - 8; kcs = kcs < 0 ? 0 : kcs; kcs = kcs > 32 ? 32 : kcs;
        const bf16* qrow = ZP + (size_t)(seqbase + r * 64 + 16 * n + l15) * 2048 + 512 + h * 64 + 8 * g;
        const bf16x8 q0 = *(const bf16x8*)qrow, q1 = *(const bf16x8*)(qrow + 32);
        f32x4 s[16];
        const bf16* kbase = ZP + (size_t)(seqbase + rs * 64 + kcs + l15) * 2048 + 1024 + h * 64 + 8 * g;
#pragma unroll
        for (int T = 0; T < 16; ++T) {
            const bf16* krow = kbase + (size_t)((T >> 1) * 64 + (T & 1) * 16) * 2048;
            const bf16x8 k0 = *(const bf16x8*)krow, k1 = *(const bf16x8*)(krow + 32);
            f32x4 z = {0.f, 0.f, 0.f, 0.f};
            z = __builtin_amdgcn_mfma_f32_16x16x32_bf16(k0, q0, z, 0, 0, 0);
            s[T] = __builtin_amdgcn_mfma_f32_16x16x32_bf16(k1, q1, z, 0, 0, 0);
        }
        const int qc = 16 * n + l15; int cs = qc - 8; cs = cs < 0 ? 0 : cs; cs = cs > 48 ? 48 : cs;
        float mx = -3.0e38f;
#pragma unroll
        for (int T = 0; T < 16; ++T) {
            const int dri = rs + (T >> 1) - r + 7;
#pragma unroll
            for (int i = 0; i < 4; ++i) {
                const int kc = kcs + (T & 1) * 16 + 4 * g + i;
                int dci = kc - qc + 15; dci = dci < 0 ? 0 : dci; dci = dci > 30 ? 30 : dci;
                const bool valid = (kc >= cs) && (kc < cs + 16);
                const float v = valid ? s[T][i] * C2 + rph[dri * 31 + dci] : -3.0e38f;
                s[T][i] = v; mx = fmaxf(mx, v);
            }
        }
        mx = fmaxf(mx, __shfl_xor(mx, 16)); mx = fmaxf(mx, __shfl_xor(mx, 32));
        float sum = 0.f;
#pragma unroll
        for (int T = 0; T < 16; ++T)
#pragma unroll
            for (int i = 0; i < 4; ++i) { const float p = __builtin_amdgcn_exp2f(s[T][i] - mx); s[T][i] = p; sum += p; }
        sum += __shfl_xor(sum, 16); sum += __shfl_xor(sum, 32);
        const float inv = 1.0f / sum;
        f32x4 o[4];
#pragma unroll
        for (int dt = 0; dt < 4; ++dt) o[dt] = (f32x4){0.f, 0.f, 0.f, 0.f};
        const bf16* vbase = ZP + (size_t)(seqbase + rs * 64 + kcs) * 2048 + 1536 + h * 64;
#pragma unroll
        for (int c = 0; c < 4; ++c) {
            v4u vr[8];
#pragma unroll
            for (int it = 0; it < 8; ++it) { const int piece = it * 64 + lane, kl = piece >> 3, dch = piece & 7;
                vr[it] = *(const v4u*)(vbase + (size_t)((2 * c + (kl >> 5)) * 64 + (kl & 31)) * 2048 + dch * 8); }
            asm volatile("" ::: "memory");
#pragma unroll
            for (int it = 0; it < 8; ++it) { const int piece = it * 64 + lane, kl = piece >> 3, dch = piece & 7;
                *(LAS v4u*)(vs + kl * VSTRIDE + dch * 16) = vr[it]; }
            LDS_WAIT(); asm volatile("" ::: "memory");
#pragma unroll
            for (int kb2 = 0; kb2 < 2; ++kb2) {
                const int kb = 2 * c + kb2;
                bf16x8 pf; { const unsigned w0 = pg8::cvt_pk_bf16(s[2 * kb][0], s[2 * kb][1]), w1 = pg8::cvt_pk_bf16(s[2 * kb][2], s[2 * kb][3]), w2 = pg8::cvt_pk_bf16(s[2 * kb + 1][0], s[2 * kb + 1][1]), w3 = pg8::cvt_pk_bf16(s[2 * kb + 1][2], s[2 * kb + 1][3]);
                    v4u pw = {w0, w1, w2, w3}; pf = __builtin_bit_cast(bf16x8, pw); }
#pragma unroll
                for (int dt = 0; dt < 4; ++dt) {
                    const LAS unsigned char* ap = vs + (kb2 * 32 + 4 * g + (l15 >> 2)) * VSTRIDE + (16 * dt + 4 * (l15 & 3)) * 2;
                    const s16x4 lo = __builtin_bit_cast(s16x4, __builtin_amdgcn_ds_read_tr16_b64_v4i16((LAS s16x4*)ap));
                    const s16x4 hi = __builtin_bit_cast(s16x4, __builtin_amdgcn_ds_read_tr16_b64_v4i16((LAS s16x4*)(ap + 16 * VSTRIDE)));
                    const bf16x8 vf = {lo[0], lo[1], lo[2], lo[3], hi[0], hi[1], hi[2], hi[3]};
                    o[dt] = __builtin_amdgcn_mfma_f32_16x16x32_bf16(vf, pf, o[dt], 0, 0, 0);
                }
            }
            LDS_WAIT(); asm volatile("" ::: "memory");
        }
        bf16* orow = ATTN + (size_t)(seqbase + r * 64 + 16 * n + l15) * NAW + h * 64 + 4 * g;
#pragma unroll
        for (int dt = 0; dt < 4; ++dt) { v2u w; w.x = pg8::cvt_pk_bf16(o[dt][0] * inv, o[dt][1] * inv); w.y = pg8::cvt_pk_bf16(o[dt][2] * inv, o[dt][3] * inv); *(v2u*)(orow + 16 * dt) = w; }
    }
}

__device__ __forceinline__ void p8_final(float* out, const float* SS2, const float* gf, int gw, int NGW, int lane) {
    f32x4 gv[4];
#pragma unroll
    for (int j = 0; j < 4; ++j) gv[j] = ((const f32x4*)gf)[lane + 64 * j];
    for (int m = gw; m < M; m += NGW) {
        const float rstd = 1.0f / sqrtf(SS2[m] * (1.f / D) + RMS_EPS);
        f32x4* yr = (f32x4*)(out + (size_t)m * D) + lane;
        f32x4 v[4];
#pragma unroll
        for (int j = 0; j < 4; ++j) v[j] = yr[64 * j];
#pragma unroll
        for (int j = 0; j < 4; ++j) yr[64 * j] = v[j] * rstd * gv[j];
    }
}

__global__ void __launch_bounds__(NWAVES * 64, 2) fwd_megakernel(Args args) {
    extern __shared__ __attribute__((aligned(16))) unsigned char lds_raw[];
    cg::grid_group grid = cg::this_grid();
    LAS unsigned char* lds = (LAS unsigned char*)lds_raw;
    const int tid = threadIdx.x, lane = tid & 63, wave = __builtin_amdgcn_readfirstlane(tid >> 6);
    const int G = gridDim.x, blk = blockIdx.x;
    const int gw = blk * NWAVES + wave, NGW = G * NWAVES;
    unsigned char* ws = args.ws;
    bf16* XN = (bf16*)(ws + WS_XN); bf16* ZP = (bf16*)(ws + WS_ZP); bf16* GT = (bf16*)(ws + WS_GT);
    bf16* POOLED = (bf16*)(ws + WS_POOLED); bf16* ATTN = (bf16*)(ws + WS_ATTN); bf16* MIX = (bf16*)(ws + WS_ZP);
    bf16* X1G = (bf16*)(ws + WS_XN); bf16* HID = (bf16*)(ws + WS_HID);
    float* SS1 = (float*)(ws + WS_SS1); float* SS2 = (float*)(ws + WS_SS2);

    p0_prologue(args, lds, gw, NGW, wave, lane);
    grid.sync();
    { pg8::Gemm g{XN, (const bf16*)(ws + WS_WIN), M, NZ, D}; pg8::StaticOrder S; S.init(M, NZ, G, blk);
      pg8::EpiZ E{ZP, GT, args.in[4]};
      pg8::gemm_phase<pg8::EpiZ, pg8::StaticOrder, true, true>(lds, g, S, E); }
    grid.sync();
    p2_pool(ZP, POOLED, gw, NGW, lane);
    p2_natten(ZP, ATTN, args.in[8], lds, blk, G, tid, wave, lane);
    grid.sync();
    { pg8::Gemm g{POOLED, (const bf16*)(ws + WS_WPP), M, D, PW}; pg8::StaticOrder S; S.init(M, D, G, blk);
      pg8::EpiMix<false> E{MIX, GT, 0};
      pg8::gemm_phase<pg8::EpiMix<false>, pg8::StaticOrder, true, true>(lds, g, S, E); }
    grid.sync();
    { pg8::Gemm g{ATTN, (const bf16*)(ws + WS_WNA), M, D, NAW}; pg8::StaticOrder S; S.init(M, D, G, blk);
      pg8::EpiMix<true> E{MIX, GT, 1024};
      pg8::gemm_phase<pg8::EpiMix<true>, pg8::StaticOrder, true, true>(lds, g, S, E); }
    grid.sync();
    { pg8::Gemm g{MIX, (const bf16*)(ws + WS_WOUT), M, D, D}; pg8::StaticOrder S; S.init(M, D, G, blk);
      pg8::EpiRes<false> E{args.in[0], args.in[1], MP, args.out, X1G, args.in[11], SS1};
      pg8::gemm_phase<pg8::EpiRes<false>, pg8::StaticOrder, true, true>(lds, g, S, E); }
    grid.sync();
    { pg8::Gemm g{X1G, (const bf16*)(ws + WS_WFF1), M, FF, D}; pg8::StaticOrder S; S.init(M, FF, G, blk);
      pg8::EpiHid E{HID, SS1, RMS_EPS};
      pg8::gemm_phase<pg8::EpiHid, pg8::StaticOrder, true, true>(lds, g, S, E); }
    grid.sync();
    { pg8::Gemm g{HID, (const bf16*)(ws + WS_WFF2), M, D, FF}; pg8::StaticOrder S; S.init(M, D, G, blk);
      pg8::EpiRes<true> E{args.out, args.out, M, args.out, nullptr, nullptr, SS2};
      pg8::gemm_phase<pg8::EpiRes<true>, pg8::StaticOrder, true, true>(lds, g, S, E); }
    grid.sync();
    p8_final(args.out, SS2, args.in[14], gw, NGW, lane);
}

extern "C" void kernel_launch(void* const* d_in, const int* in_sizes, int n_in, void* d_out, int out_size, void* d_ws, size_t ws_size, hipStream_t stream) {
    static int grid_blocks = 0;
    if (!grid_blocks) {
        if (n_in != 15 || out_size != M * D || ws_size < WS_END) { fprintf(stderr, "kernel_launch: unexpected shapes (n_in %d out %d ws %zu)\n", n_in, out_size, ws_size); grid_blocks = -1; return; }
        int dev = 0, cus = 0, per_cu = 0;
        (void)hipGetDevice(&dev);
        (void)hipDeviceGetAttribute(&cus, hipDeviceAttributeMultiprocessorCount, dev);
        (void)hipFuncSetAttribute((const void*)fwd_megakernel, hipFuncAttributeMaxDynamicSharedMemorySize, LDS_BYTES);
        (void)hipOccupancyMaxActiveBlocksPerMultiprocessor(&per_cu, (const void*)fwd_megakernel, NWAVES * 64, LDS_BYTES);
        if (per_cu < 1) per_cu = 1;
        grid_blocks = cus * per_cu;
    }
    if (grid_blocks < 0) return;
    Args a{};
    for (int i = 0; i < 15; ++i) a.in[i] = (const float*)d_in[i];
    a.out = (float*)d_out; a.ws = (unsigned char*)d_ws;
    void* kargs[] = {&a};
    hipError_t e = hipLaunchCooperativeKernel((const void*)fwd_megakernel, dim3(grid_blocks), dim3(NWAVES * 64), kargs, LDS_BYTES, stream);
    if (e != hipSuccess) fprintf(stderr, "cooperative launch failed: %s (grid %d)\n", hipGetErrorString(e), grid_blocks);
}
```

```cpp
#include <hip/hip_runtime.h>
#include <hip/hip_cooperative_groups.h>
#include <cstdio>
#include <cstdint>
namespace cg = cooperative_groups;
namespace pg8 {
#define PG8_LAS __attribute__((address_space(3)))
typedef unsigned short bf16_t;
typedef short bf16x8 __attribute__((ext_vector_type(8)));
typedef float f32x4 __attribute__((ext_vector_type(4)));
typedef unsigned u32x4 __attribute__((ext_vector_type(4)));
constexpr int BM = 256, BK = 64, HALF = 128, HTB = HALF * BK * 2  , STAGE_BYTES = 8 * HTB, NXCD = 8, WGM = 8;

__host__ __device__ __forceinline__ int lds_byte(int r, int c) { const int st = (r >> 4) * 2 + (c >> 5), rr = r & 15, cc = c & 31, ob = rr * 64 + cc * 2; return st * 1024 + (ob ^ (((ob >> 9) & 1) << 5)); }
__host__ __device__ __forceinline__ void stage_rc(int b, int& R, int& C) { const int st = b / 1024, sb = b % 1024, swz = sb ^ (((sb >> 9) & 1) << 5); R = (st >> 1) * 16 + swz / 64; C = (st & 1) * 32 + (swz % 64) / 2; }
__host__ __device__ __forceinline__ int perm32(int rho) { const int n = rho >> 4, i = rho & 15; return 8 * (i >> 2) + 4 * n + (i & 3); }

struct Unit { int pm, pn; };
struct Gemm { const bf16_t* A; const bf16_t* Bt; int M, N, K; };

struct StaticOrder {
    int nM, nN, nwg, G, c;
    __host__ __device__ void init(int M, int N, int G_, int c_) { nM = M / BM; nN = N / BM; nwg = nM * nN; G = G_; c = c_; }
    __host__ __device__ bool next(int i, Unit& u) const {
        const long L = (long)i * G + c; if (L >= nwg) return false;
        int wgid = (int)L; { const int q = nwg / NXCD, r = nwg % NXCD, xcd = wgid % NXCD, off = wgid / NXCD; wgid = (xcd < r ? xcd * (q + 1) : r * (q + 1) + (xcd - r) * q) + off; }
        const int nig = WGM * nN, gid = wgid / nig, fm = gid * WGM, gsz = (nM - fm) < WGM ? (nM - fm) : WGM;
        u.pm = fm + ((wgid % nig) % gsz); u.pn = (wgid % nig) / gsz; return true;
    }
    __device__ __forceinline__ void a_ready(const Unit&) const {}
    __device__ __forceinline__ void done(const Unit&) const {}
};

__device__ __forceinline__ unsigned cvt_pk_bf16(float lo, float hi) { unsigned r; asm volatile("v_cvt_pk_bf16_f32 %0, %1, %2" : "=v"(r) : "v"(lo), "v"(hi)); return r; }
typedef float f32x2 __attribute__((ext_vector_type(2)));
__device__ __forceinline__ float bf_lo(unsigned w) { return __uint_as_float(w << 16); }
__device__ __forceinline__ float bf_hi(unsigned w) { return __uint_as_float(w & 0xffff0000u); }
__device__ __forceinline__ float sigmoidf_fast(float x) { return __builtin_amdgcn_rcpf(1.0f + __builtin_amdgcn_exp2f(-1.4426950408889634f * x)); }
__device__ __forceinline__ u32x4 pack8(const f32x4 v0, const f32x4 v1) { u32x4 w; w.x = cvt_pk_bf16(v0[0], v0[1]); w.y = cvt_pk_bf16(v0[2], v0[3]); w.z = cvt_pk_bf16(v1[0], v1[1]); w.w = cvt_pk_bf16(v1[2], v1[3]); return w; }
__device__ __forceinline__ void unpack8(const u32x4 w, f32x4& v0, f32x4& v1) { v0 = (f32x4){bf_lo(w.x), bf_hi(w.x), bf_lo(w.y), bf_hi(w.y)}; v1 = (f32x4){bf_lo(w.z), bf_hi(w.z), bf_lo(w.w), bf_hi(w.w)}; }

struct EpiZ {
    static constexpr bool PERM = true, AFTER_DRAIN = false;
    bf16_t* PB; bf16_t* QKV; bf16_t* GT; const float* bgate;
    __device__ __forceinline__ void operator()(const f32x4 (&acc)[2][2][4][2], const Unit& u, int wr, int wc, int fr, int fq) const {
        constexpr size_t MTOK = 81920;
        const int row0 = u.pm * BM + wr * 64 + fr; const bool gate = u.pn >= 8;
        f32x4 bv[2][2];
        const int gcol0 = (u.pn & 7) * BM + wc * 32 + 8 * fq;
#pragma unroll
        for (int bj = 0; bj < 2; ++bj)
#pragma unroll
            for (int n = 0; n < 2; ++n) bv[bj][n] = gate ? *(const f32x4*)(bgate + gcol0 + bj * HALF + 4 * n) : (f32x4){0.f, 0.f, 0.f, 0.f};
        bf16_t* base; size_t rstride, bjstep;
        if (gate) { base = GT + gcol0; rstride = 2048; bjstep = HALF; }
        else if (u.pn < 2) { base = PB + u.pn * BM + wc * 32 + 8 * fq; rstride = 512; bjstep = HALF; }
        else { const int which = (u.pn - 2) >> 1, cw = ((u.pn - 2) & 1) * BM + wc * 32 + 8 * fq;
            base = QKV + (size_t)which * MTOK * 512 + (size_t)(cw >> 6) * MTOK * 64 + (cw & 63); rstride = 64; bjstep = 2 * MTOK * 64; }
#pragma unroll
        for (int ai = 0; ai < 2; ++ai)
#pragma unroll
            for (int m = 0; m < 4; ++m) { bf16_t* rowp = base + (size_t)(row0 + ai * HALF + m * 16) * rstride;
#pragma unroll
                for (int bj = 0; bj < 2; ++bj) { f32x4 v0 = acc[ai][bj][m][0], v1 = acc[ai][bj][m][1];
                    if (gate) { v0 += bv[bj][0]; v1 += bv[bj][1];
#pragma unroll
                        for (int e = 0; e < 4; ++e) { v0[e] = sigmoidf_fast(v0[e]); v1[e] = sigmoidf_fast(v1[e]); } }
                    *(u32x4*)(rowp + bj * bjstep) = pack8(v0, v1); } }
    }
};
template <bool ADD> struct EpiMix {
    static constexpr bool PERM = true, AFTER_DRAIN = false;
    bf16_t* MIX; const bf16_t* GT; int gcol0;
    __device__ __forceinline__ void operator()(const f32x4 (&acc)[2][2][4][2], const Unit& u, int wr, int wc, int fr, int fq) const {
        const int row0 = u.pm * BM + wr * 64 + fr; const int col0 = u.pn * BM + wc * 32 + 8 * fq;
#pragma unroll
        for (int ai = 0; ai < 2; ++ai)
#pragma unroll
            for (int m = 0; m < 4; ++m) { const size_t row = (size_t)(row0 + ai * HALF + m * 16);
#pragma unroll
                for (int bj = 0; bj < 2; ++bj) {
                    const u32x4 gw = *(const u32x4*)(GT + row * 2048 + gcol0 + col0 + bj * HALF);
                    f32x4 g0, g1; unpack8(gw, g0, g1);
                    f32x4 v0 = acc[ai][bj][m][0] * g0, v1 = acc[ai][bj][m][1] * g1;
                    bf16_t* op = MIX + row * 1024 + col0 + bj * HALF;
                    if (ADD) { const u32x4 ow = *(const u32x4*)op; f32x4 o0, o1; unpack8(ow, o0, o1); v0 += o0; v1 += o1; }
                    *(u32x4*)op = pack8(v0, v1); } }
    }
};
template <bool FINAL> struct EpiRes {
    static constexpr bool PERM = true, AFTER_DRAIN = false;
    const float* xa; const float* xb; int msplit;
    float* X1; bf16_t* X1G; const float* gmlp; float* SS;
    __device__ __forceinline__ void operator()(const f32x4 (&acc)[2][2][4][2], const Unit& u, int wr, int wc, int fr, int fq) const {
        const int row0 = u.pm * BM + wr * 64 + fr; const int col0 = u.pn * BM + wc * 32 + 8 * fq;
        const float* xs = (u.pm * BM < msplit) ? xa : xb - (size_t)msplit * 1024;
        f32x4 gv[2][2];
        if (!FINAL) {
#pragma unroll
            for (int bj = 0; bj < 2; ++bj)
#pragma unroll
                for (int n = 0; n < 2; ++n) gv[bj][n] = *(const f32x4*)(gmlp + col0 + bj * HALF + 4 * n);
        }
#pragma unroll
        for (int ai = 0; ai < 2; ++ai)
#pragma unroll
            for (int m = 0; m < 4; ++m) { const size_t row = (size_t)(row0 + ai * HALF + m * 16); float ss = 0.f;
#pragma unroll
                for (int bj = 0; bj < 2; ++bj) { const size_t off = row * 1024 + col0 + bj * HALF;
                    const f32x4 x0 = *(const f32x4*)(xs + off), x1 = *(const f32x4*)(xs + off + 4);
                    const f32x4 v0 = acc[ai][bj][m][0] + x0, v1 = acc[ai][bj][m][1] + x1;
                    *(f32x4*)(X1 + off) = v0; *(f32x4*)(X1 + off + 4) = v1;
                    ss += (v0[0] * v0[0] + v0[1] * v0[1]) + (v0[2] * v0[2] + v0[3] * v0[3]) + (v1[0] * v1[0] + v1[1] * v1[1]) + (v1[2] * v1[2] + v1[3] * v1[3]);
                    if (!FINAL) *(u32x4*)(X1G + off) = pack8(v0 * gv[bj][0], v1 * gv[bj][1]); }
                ss += __shfl_xor(ss, 16); ss += __shfl_xor(ss, 32);
                if (fq == 0) atomicAdd(SS + row, ss); }
    }
};
struct EpiHid {
    static constexpr bool PERM = true, AFTER_DRAIN = false;
    bf16_t* HID; const float* SS; float eps;
    __device__ __forceinline__ void operator()(const f32x4 (&acc)[2][2][4][2], const Unit& u, int wr, int wc, int fr, int fq) const {
        const int row0 = u.pm * BM + wr * 64 + fr; const int col0 = u.pn * BM + wc * 32 + 8 * fq;
#pragma unroll
        for (int ai = 0; ai < 2; ++ai)
#pragma unroll
            for (int m = 0; m < 4; ++m) { const size_t row = (size_t)(row0 + ai * HALF + m * 16);
                const float rs = __builtin_amdgcn_rsqf(SS[row] * (1.0f / 1024.0f) + eps);
#pragma unroll
                for (int bj = 0; bj < 2; ++bj) { f32x4 v0 = acc[ai][bj][m][0] * rs, v1 = acc[ai][bj][m][1] * rs;
#pragma unroll
                    for (int e = 0; e < 4; ++e) { const float a = fmaxf(v0[e], 0.f), b = fmaxf(v1[e], 0.f); v0[e] = a * a; v1[e] = b * b; }
                    *(u32x4*)(HID + row * 4096 + col0 + bj * HALF) = pack8(v0, v1); } }
    }
};

template <class Epi, class Sched, bool ALIGN_EPI = false, bool SP2 = false>
__device__ __forceinline__ void gemm_phase(PG8_LAS unsigned char* lds, const Gemm g, const Sched& S, const Epi& E) {
    const int tid = threadIdx.x, wid = __builtin_amdgcn_readfirstlane(tid >> 6), lane = tid & 63, wr = wid >> 2, wc = wid & 3, fr = lane & 15, fq = lane >> 4;
    const int K = g.K, nt = K / BK;
    unsigned voffA[2], voffB[2];
#pragma unroll
    for (int i = 0; i < 2; ++i) { int R, C; stage_rc(tid * 16 + i * 8192, R, C); const int Rb = Epi::PERM ? ((R & ~31) + perm32(R & 31)) : R;
        voffA[i] = (unsigned)(R * K + C) * 2u; voffB[i] = (unsigned)(Rb * K + C) * 2u; }
    const size_t kstep = (size_t)(BK * 2);
    const size_t hstep = (size_t)HALF * K * 2;
    const size_t tstep = 2 * hstep;
    const unsigned ldsw = (unsigned)wid * 1024u;
    const int aoff = lds_byte(wr * 64 + fr, fq * 8), boff = lds_byte(wc * 32 + fr, fq * 8);
#define PG8_SA(b, h) (((b) * 2 + (h)) * HTB)
#define PG8_SB(b, h) ((4 + (b) * 2 + (h)) * HTB)
#define PG8_STAGE(bufoff, gbase, voff) do { _Pragma("unroll") for (int _i = 0; _i < 2; ++_i) \
        __builtin_amdgcn_global_load_lds((const unsigned*)((const char*)(gbase) + (voff)[_i]), (PG8_LAS unsigned*)(lds + (bufoff) + ldsw + _i * 8192), 16, 0, 0); } while (0)
#define PG8_LDA(dst, b, h) do { _Pragma("unroll") for (int m = 0; m < 4; ++m) _Pragma("unroll") for (int k = 0; k < 2; ++k) dst[m][k] = *(const PG8_LAS bf16x8*)(lds + PG8_SA(b, h) + aoff + m * 2048 + k * 1024); } while (0)
#define PG8_LDB(dst, b, h) do { _Pragma("unroll") for (int n = 0; n < 2; ++n) _Pragma("unroll") for (int k = 0; k < 2; ++k) dst[n][k] = *(const PG8_LAS bf16x8*)(lds + PG8_SB(b, h) + boff + n * 2048 + k * 1024); } while (0)
#define PG8_MMA(ai, bj, At, Bt) do { __builtin_amdgcn_s_setprio(1); _Pragma("unroll") for (int m = 0; m < 4; ++m) _Pragma("unroll") for (int n = 0; n < 2; ++n) _Pragma("unroll") for (int k = 0; k < 2; ++k) \
        acc[ai][bj][m][n] = __builtin_amdgcn_mfma_f32_16x16x32_bf16(Bt[n][k], At[m][k], acc[ai][bj][m][n], 0, 0, 0); __builtin_amdgcn_s_setprio(0); } while (0)
#define PG8_WAIT_V(n) asm volatile("s_waitcnt vmcnt(" #n ")" ::: "memory")
#define PG8_WAIT_L(n) asm volatile("s_waitcnt lgkmcnt(" #n ")" ::: "memory")
#define PG8_BAR __builtin_amdgcn_s_barrier()
#define PG8_SCHED __builtin_amdgcn_sched_barrier(0)
    Unit cur, nxt; int ui = 0;
    if (!S.next(0, cur)) return;
    f32x4 acc[2][2][4][2];
#pragma unroll
    for (int a = 0; a < 2; ++a)
#pragma unroll
        for (int b = 0; b < 2; ++b)
#pragma unroll
            for (int m = 0; m < 4; ++m)
#pragma unroll
                for (int n = 0; n < 2; ++n) acc[a][b][m][n] = (f32x4){0.f, 0.f, 0.f, 0.f};
    bf16x8 At[4][2], B0[2][2], B1[2][2];
    const char* cA = (const char*)g.A + (size_t)cur.pm * tstep; const char* cB = (const char*)g.Bt + (size_t)cur.pn * tstep;
    S.a_ready(cur);
    if constexpr (SP2) {
        PG8_STAGE(PG8_SB(0, 0), cB, voffB); PG8_STAGE(PG8_SB(0, 1), cB + hstep, voffB); PG8_STAGE(PG8_SA(0, 0), cA, voffA); PG8_STAGE(PG8_SA(0, 1), cA + hstep, voffA);
        if (wr == 1) PG8_BAR;
        PG8_WAIT_V(2); PG8_BAR;
        PG8_STAGE(PG8_SB(1, 0), cB + kstep, voffB); PG8_STAGE(PG8_SA(1, 0), cA + kstep, voffA); PG8_STAGE(PG8_SB(1, 1), cB + hstep + kstep, voffB);
        PG8_WAIT_V(6); PG8_BAR;
    } else {
        PG8_STAGE(PG8_SB(0, 0), cB, voffB); PG8_STAGE(PG8_SA(0, 0), cA, voffA); PG8_STAGE(PG8_SB(0, 1), cB + hstep, voffB); PG8_STAGE(PG8_SA(0, 1), cA + hstep, voffA);
        if (wr == 1) PG8_BAR;
        PG8_WAIT_V(4); PG8_BAR;
        PG8_STAGE(PG8_SB(1, 0), cB + kstep, voffB); PG8_STAGE(PG8_SA(1, 0), cA + kstep, voffA); PG8_STAGE(PG8_SB(1, 1), cB + hstep + kstep, voffB);
        PG8_WAIT_V(6); PG8_BAR;
    }
    for (;;) {
        const bool has_next = S.next(ui + 1, nxt);
        const char* nA = has_next ? (const char*)g.A + (size_t)nxt.pm * tstep : cA; const char* nB = has_next ? (const char*)g.Bt + (size_t)nxt.pn * tstep : cB;
        for (int t = 0; t < nt; t += 2) {
            const bool last = (t == nt - 2);
            const char* a1 = cA + (size_t)(t + 1) * kstep;
            const char* a2 = last ? nA : cA + (size_t)(t + 2) * kstep; const char* b2 = last ? nB : cB + (size_t)(t + 2) * kstep;
            const char* a3 = a2 + kstep; const char* b3 = b2 + kstep;
            if (last && has_next) S.a_ready(nxt);
            if constexpr (SP2) {
            PG8_LDB(B0, 0, 0); PG8_LDB(B1, 0, 1); PG8_SCHED; PG8_LDA(At, 0, 0); PG8_STAGE(PG8_SA(1, 1), a1 + hstep, voffA);
            PG8_WAIT_V(8); PG8_WAIT_L(0); PG8_BAR; PG8_MMA(0, 0, At, B0); PG8_MMA(0, 1, At, B1); PG8_BAR; PG8_SCHED;
            PG8_LDA(At, 0, 1); PG8_STAGE(PG8_SB(0, 0), b2, voffB); PG8_STAGE(PG8_SB(0, 1), b2 + hstep, voffB); PG8_STAGE(PG8_SA(0, 0), a2, voffA);
            PG8_WAIT_V(8); PG8_WAIT_L(0); PG8_BAR; PG8_MMA(1, 0, At, B0); PG8_MMA(1, 1, At, B1); PG8_BAR; PG8_SCHED;
            PG8_LDB(B0, 1, 0); PG8_LDB(B1, 1, 1); PG8_SCHED; PG8_LDA(At, 1, 0); PG8_STAGE(PG8_SA(0, 1), a2 + hstep, voffA);
            PG8_WAIT_V(8); PG8_WAIT_L(0); PG8_BAR; PG8_MMA(0, 0, At, B0); PG8_MMA(0, 1, At, B1); PG8_BAR; PG8_SCHED;
            PG8_LDA(At, 1, 1); PG8_STAGE(PG8_SB(1, 0), b3, voffB); PG8_STAGE(PG8_SB(1, 1), b3 + hstep, voffB); PG8_STAGE(PG8_SA(1, 0), a3, voffA);
            PG8_WAIT_V(8); PG8_WAIT_L(0); PG8_BAR; PG8_MMA(1, 0, At, B0); PG8_MMA(1, 1, At, B1); PG8_BAR; PG8_SCHED;
            } else {
            PG8_LDB(B0, 0, 0); PG8_SCHED; PG8_LDA(At, 0, 0); PG8_STAGE(PG8_SA(1, 1), a1 + hstep, voffA);
            PG8_WAIT_L(8); PG8_BAR; PG8_WAIT_L(0); PG8_MMA(0, 0, At, B0); PG8_BAR; PG8_SCHED;
            PG8_LDB(B1, 0, 1); PG8_STAGE(PG8_SB(0, 0), b2, voffB);
            PG8_BAR; PG8_WAIT_L(0); PG8_MMA(0, 1, At, B1); PG8_BAR;
            PG8_LDA(At, 0, 1); PG8_STAGE(PG8_SA(0, 0), a2, voffA);
            PG8_BAR; PG8_WAIT_L(0); PG8_MMA(1, 0, At, B0); PG8_BAR; PG8_SCHED;
            PG8_STAGE(PG8_SB(0, 1), b2 + hstep, voffB);
            PG8_WAIT_V(6); PG8_BAR; PG8_MMA(1, 1, At, B1); PG8_BAR;
            PG8_LDB(B0, 1, 0); PG8_SCHED; PG8_LDA(At, 1, 0); PG8_STAGE(PG8_SA(0, 1), a2 + hstep, voffA);
            PG8_WAIT_L(8); PG8_BAR; PG8_WAIT_L(0); PG8_MMA(0, 0, At, B0); PG8_BAR; PG8_SCHED;
            PG8_LDB(B1, 1, 1); PG8_STAGE(PG8_SB(1, 0), b3, voffB);
            PG8_BAR; PG8_WAIT_L(0); PG8_MMA(0, 1, At, B1); PG8_BAR;
            PG8_LDA(At, 1, 1); PG8_STAGE(PG8_SA(1, 0), a3, voffA);
            PG8_BAR; PG8_WAIT_L(0); PG8_MMA(1, 0, At, B0); PG8_BAR; PG8_SCHED;
            PG8_STAGE(PG8_SB(1, 1), b3 + hstep, voffB);
            PG8_WAIT_V(6); PG8_BAR; PG8_MMA(1, 1, At, B1); PG8_BAR;
            }
        }
        if constexpr (ALIGN_EPI) { if (wr == 0) PG8_BAR; }
        if constexpr (!Epi::AFTER_DRAIN) { E(acc, cur, wr, wc, fr, fq); S.done(cur); }
        if (!has_next) break;
#pragma unroll
        for (int a = 0; a < 2; ++a)
#pragma unroll
            for (int b = 0; b < 2; ++b)
#pragma unroll
                for (int m = 0; m < 4; ++m)
#pragma unroll
                    for (int n = 0; n < 2; ++n) acc[a][b][m][n] = (f32x4){0.f, 0.f, 0.f, 0.f};
        cur = nxt; cA = nA; cB = nB; ++ui;
        if constexpr (ALIGN_EPI) { if (wr == 1) PG8_BAR; }
    }
    PG8_WAIT_V(0);
    if constexpr (!ALIGN_EPI) { if (wr == 0) PG8_BAR; }
    PG8_BAR;
    if constexpr (Epi::AFTER_DRAIN) { E.fused(acc, cur, wr, wc, fr, fq, lds, wid, lane); S.done(cur); }
#undef PG8_SA
#undef PG8_SB
#undef PG8_STAGE
#undef PG8_LDA
#undef PG8_LDB
#undef PG8_MMA
#undef PG8_WAIT_V
#undef PG8_WAIT_L
#undef PG8_BAR
#undef PG8_SCHED
}
}

constexpr int D = 1024, MP = 8 * 8192, MS = 8 * 2048, M = MP + MS, FF = 4096, NZ = 4096, PW = 512, NAW = 512;
constexpr float RMS_EPS = 1e-6f;
constexpr size_t MiB = 1u << 20;
constexpr size_t WS_WIN = 0, WS_WPP = 8 * MiB, WS_WNA = 9 * MiB, WS_WOUT = 10 * MiB, WS_WFF1 = 12 * MiB, WS_WFF2 = 20 * MiB;
constexpr size_t WS_SS1 = 28 * MiB, WS_SS2 = 29 * MiB;
constexpr size_t WS_XN = 32 * MiB;
constexpr size_t WS_POOLED = WS_XN, WS_ATTN = WS_XN + (size_t)M * 512 * 2;
constexpr size_t WS_ZP = 192 * MiB;
constexpr size_t WS_QH = WS_ZP + (size_t)M * 512 * 2;
constexpr size_t WS_GT = 512 * MiB;
constexpr size_t WS_HID = WS_ZP;
constexpr size_t WS_END = 832 * MiB;
static_assert(WS_XN + (size_t)M * 1024 * 2 <= WS_ZP && WS_ZP + (size_t)M * 2048 * 2 <= WS_GT && WS_GT + (size_t)M * 2048 * 2 <= WS_END && WS_HID + (size_t)M * 4096 * 2 <= WS_END, "ws map");

constexpr int NWAVES = 8, LDS_BYTES = 147456;
#define LAS __attribute__((address_space(3)))
typedef unsigned short bf16;
typedef unsigned v4u __attribute__((ext_vector_type(4)));
typedef unsigned v2u __attribute__((ext_vector_type(2)));
typedef float f32x4 __attribute__((ext_vector_type(4)));
typedef short bf16x8 __attribute__((ext_vector_type(8)));
typedef short s16x4 __attribute__((ext_vector_type(4)));
#define LDS_WAIT() asm volatile("s_waitcnt lgkmcnt(0)" ::: "memory")
__device__ __forceinline__ unsigned f2bf(float f) { unsigned u = __builtin_bit_cast(unsigned, f); return (u + 0x7fffu + ((u >> 16) & 1u)) >> 16; }
__device__ __forceinline__ unsigned pk2(float lo, float hi) { return f2bf(lo) | (f2bf(hi) << 16); }
__device__ __forceinline__ float wave_sum(float v) {
#pragma unroll
    for (int o = 1; o < 64; o <<= 1) v += __shfl_xor(v, o);
    return v;
}

struct Args { const float* in[15]; float* out; unsigned char* ws; };

__device__ __forceinline__ void p0_transpose_item(const float* W, int K, int N, bf16* WT, LAS float* scr, int item, int lane) {
    const int nblk = N / 32, kb = item / nblk, nb = item % nblk, k0 = 64 * kb, n0 = 32 * nb;
#pragma unroll 8
    for (int i = 0; i < 32; ++i) { const int kk = 2 * i + (lane >> 5); scr[kk * 33 + (lane & 31)] = W[(size_t)(k0 + kk) * N + n0 + (lane & 31)]; }
    LDS_WAIT(); asm volatile("" ::: "memory");
    const int c = lane & 7;
#pragma unroll
    for (int j = 0; j < 4; ++j) { const int n = (lane >> 3) + 8 * j; const LAS float* s = scr + (8 * c) * 33 + n;
        v4u o; o.x = pk2(s[0 * 33], s[1 * 33]); o.y = pk2(s[2 * 33], s[3 * 33]); o.z = pk2(s[4 * 33], s[5 * 33]); o.w = pk2(s[6 * 33], s[7 * 33]);
        *(v4u*)(WT + (size_t)(n0 + n) * K + k0 + 8 * c) = o; }
    LDS_WAIT(); asm volatile("" ::: "memory");
}

__device__ __forceinline__ void p0_prologue(const Args& a, LAS unsigned char* lds, int gw, int NGW, int wave, int lane) {
    unsigned char* ws = a.ws;
    LAS float* scr = (LAS float*)(lds + wave * 16384);
    constexpr int I_IN = (D / 64) * (NZ / 32), I_NA = (NAW / 64) * (D / 32), I_OUT = (D / 64) * (D / 32), I_F1 = (D / 64) * (FF / 32), I_F2 = (FF / 64) * (D / 32);
    constexpr int NITEMS = I_IN + I_NA + I_OUT + I_F1 + I_F2;
    for (int it = gw; it < NITEMS; it += NGW) {
        int r = it;
        if (r < I_IN) { p0_transpose_item(a.in[3], D, NZ, (bf16*)(ws + WS_WIN), scr, r, lane); continue; } r -= I_IN;
        if (r < I_NA) { p0_transpose_item(a.in[9], NAW, D, (bf16*)(ws + WS_WNA), scr, r, lane); continue; } r -= I_NA;
        if (r < I_OUT) { p0_transpose_item(a.in[10], D, D, (bf16*)(ws + WS_WOUT), scr, r, lane); continue; } r -= I_OUT;
        if (r < I_F1) { p0_transpose_item(a.in[12], D, FF, (bf16*)(ws + WS_WFF1), scr, r, lane); continue; } r -= I_F1;
        p0_transpose_item(a.in[13], FF, D, (bf16*)(ws + WS_WFF2), scr, r, lane);
    }
    {
        const float* wg = a.in[5]; const float* sc = a.in[6]; const float* wp = a.in[7]; bf16* WPP = (bf16*)(ws + WS_WPP);
        for (int it = NGW - 1 - gw; it < 64 * 16; it += NGW) {
            const int cc = it >> 4, nb = it & 15, g = cc >> 4, c0 = (cc & 15) * 8, n = nb * 64 + lane;
            float acc[8];
#pragma unroll
            for (int j = 0; j < 8; ++j) acc[j] = 0.f;
            for (int d = 0; d < 128; ++d) {
                const float pv = wp[(size_t)(g * 128 + d) * D + n] * sc[g * 128 + d];
#pragma unroll
                for (int j = 0; j < 8; ++j) acc[j] += wg[(size_t)(g * 128 + c0 + j) * 128 + d] * pv;
            }
            v4u o; o.x = pk2(acc[0], acc[1]); o.y = pk2(acc[2], acc[3]); o.z = pk2(acc[4], acc[5]); o.w = pk2(acc[6], acc[7]);
            *(v4u*)(WPP + (size_t)n * PW + g * 128 + c0) = o;
        }
    }
    {
        float* ss1 = (float*)(ws + WS_SS1); float* ss2 = (float*)(ws + WS_SS2);
        for (int i = gw * 64 + lane; i < M; i += NGW * 64) { ss1[i] = 0.f; ss2[i] = 0.f; }
    }
    {
        const float* gm = a.in[2]; bf16* XN = (bf16*)(ws + WS_XN);
        f32x4 gv[4];
#pragma unroll
        for (int j = 0; j < 4; ++j) gv[j] = ((const f32x4*)gm)[lane + 64 * j];
        for (int m = gw; m < M; m += NGW) {
            const float* xrow = (m < MP) ? a.in[0] + (size_t)m * D : a.in[1] + (size_t)(m - MP) * D;
            const f32x4* xr = (const f32x4*)xrow + lane;
            f32x4 v[4]; float s = 0.f;
#pragma unroll
            for (int j = 0; j < 4; ++j) { v[j] = xr[64 * j]; s += (v[j].x * v[j].x + v[j].y * v[j].y) + (v[j].z * v[j].z + v[j].w * v[j].w); }
            const float rstd = 1.0f / sqrtf(wave_sum(s) * (1.f / D) + RMS_EPS);
            unsigned long long* o8 = (unsigned long long*)(XN + (size_t)m * D) + lane;
#pragma unroll
            for (int j = 0; j < 4; ++j) { const f32x4 w = v[j] * rstd * gv[j]; o8[64 * j] = (unsigned long long)pk2(w.x, w.y) | ((unsigned long long)pk2(w.z, w.w) << 32); }
        }
    }
}

template <int HW> __device__ __forceinline__ void pool_chunk(const bf16* PB, bf16* POOLED, int m0, int t0, int S, int ch) {
    constexpr int NR = 8 + 2 * HW;
    v4u w[NR];
#pragma unroll
    for (int k = 0; k < NR; ++k) { const int tt = t0 - HW + k; w[k] = (v4u){0u, 0u, 0u, 0u};
        if (tt >= 0 && tt < S) w[k] = *(const v4u*)(PB + (size_t)(m0 - HW + k) * PW + ch); }
    float s[8];
#pragma unroll
    for (int e = 0; e < 8; ++e) s[e] = 0.f;
#pragma unroll
    for (int k = 0; k < 2 * HW; ++k) { s[0] += pg8::bf_lo(w[k].x); s[1] += pg8::bf_hi(w[k].x); s[2] += pg8::bf_lo(w[k].y); s[3] += pg8::bf_hi(w[k].y);
        s[4] += pg8::bf_lo(w[k].z); s[5] += pg8::bf_hi(w[k].z); s[6] += pg8::bf_lo(w[k].w); s[7] += pg8::bf_hi(w[k].w); }
#pragma unroll
    for (int i = 0; i < 8; ++i) {
        const int t = t0 + i; const int lo = (t - HW > 0) ? t - HW : 0, hi = (t + HW < S) ? t + HW : S;
        const float inv = 1.0f / (float)(hi - lo);
        const v4u sf = w[i + HW];
        v4u o; o.x = pk2(s[0] * inv - pg8::bf_lo(sf.x), s[1] * inv - pg8::bf_hi(sf.x)); o.y = pk2(s[2] * inv - pg8::bf_lo(sf.y), s[3] * inv - pg8::bf_hi(sf.y));
        o.z = pk2(s[4] * inv - pg8::bf_lo(sf.z), s[5] * inv - pg8::bf_hi(sf.z)); o.w = pk2(s[6] * inv - pg8::bf_lo(sf.w), s[7] * inv - pg8::bf_hi(sf.w));
        *(v4u*)(POOLED + (size_t)(m0 + i) * PW + ch) = o;
        if (i < 7) { const v4u a = w[i + 2 * HW], b = w[i];
            s[0] += pg8::bf_lo(a.x) - pg8::bf_lo(b.x); s[1] += pg8::bf_hi(a.x) - pg8::bf_hi(b.x); s[2] += pg8::bf_lo(a.y) - pg8::bf_lo(b.y); s[3] += pg8::bf_hi(a.y) - pg8::bf_hi(b.y);
            s[4] += pg8::bf_lo(a.z) - pg8::bf_lo(b.z); s[5] += pg8::bf_hi(a.z) - pg8::bf_hi(b.z); s[6] += pg8::bf_lo(a.w) - pg8::bf_lo(b.w); s[7] += pg8::bf_hi(a.w) - pg8::bf_hi(b.w); }
    }
}
__device__ __forceinline__ void p2_pool(const bf16* PB, bf16* POOLED, int gw, int NGW, int lane) {
    constexpr int NCH = (M / 32) * 4;
    for (int it = gw; it < NCH; it += NGW) {
        const int c32 = it >> 2, gq = (it + (it >> 11)) & 3;
        const int m0 = c32 * 32 + (lane >> 4) * 8, ch = gq * 128 + (lane & 15) * 8;
        int t0, S; if (m0 < MP) { t0 = m0 & 8191; S = 8192; } else { t0 = (m0 - MP) & 2047; S = 2048; }
        if (gq == 0) pool_chunk<1>(PB, POOLED, m0, t0, S, ch);
        else if (gq == 1) pool_chunk<2>(PB, POOLED, m0, t0, S, ch);
        else if (gq == 2) pool_chunk<4>(PB, POOLED, m0, t0, S, ch);
        else pool_chunk<8>(PB, POOLED, m0, t0, S, ch);
    }
}

constexpr int VSTRIDE = 160;
constexpr int VBUF_BYTES = 32 * VSTRIDE;
constexpr int RPB_OFF = 8 * VBUF_BYTES;
__device__ __forceinline__ int na_rs(int r, int rows) { int rs = r - 4; rs = rs < 0 ? 0 : rs; return rs > rows - 8 ? rows - 8 : rs; }
__device__ __forceinline__ void p2_natten(const bf16* QH, const bf16* KH, const bf16* VH, bf16* ATTN, const float* rpb, LAS unsigned char* lds, int blk, int G, int tid, int wave, int lane) {
    LAS float* rp = (LAS float*)(lds + RPB_OFF);
    for (int i = tid; i < 8 * 15 * 31; i += NWAVES * 64) rp[i] = rpb[i] * 1.4426950408889634f;
    __syncthreads();
    const int h = wave, l15 = lane & 15, g = lane >> 4;
    LAS unsigned char* vs = lds + wave * VBUF_BYTES;
    const LAS float* rph = rp + h * 15 * 31;
    const bf16* Qh = QH + (size_t)h * M * 64; const bf16* Kh = KH + (size_t)h * M * 64; const bf16* Vh = VH + (size_t)h * M * 64;
    constexpr int NUNITS = 8 * 4 * 32 + 8 * 4 * 8;
    const int per = (NUNITS + G - 1) / G;
    const int u0 = blk * per, u1 = (u0 + per < NUNITS) ? u0 + per : NUNITS;
    const float C2 = 0.125f * 1.4426950408889634f;
    const LAS unsigned char* trp = vs + (4 * g + (l15 >> 2)) * VSTRIDE + 8 * (l15 & 3);
    for (int u = u0; u < u1; ++u) {
        int seqbase, n, r0, rows;
        if (u < 1024) { seqbase = (u >> 7) * 8192; const int rem = u & 127; n = rem >> 5; r0 = (rem & 31) * 4; rows = 128; }
        else { const int v = u - 1024; seqbase = MP + (v >> 5) * 2048; const int rem = v & 31; n = rem >> 3; r0 = (rem & 7) * 4; rows = 32; }
        int kcs = 16 * n - 8; kcs = kcs < 0 ? 0 : kcs; kcs = kcs > 32 ? 32 : kcs;
        const int qc = 16 * n + l15; int cs = qc - 8; cs = cs < 0 ? 0 : cs; cs = cs > 48 ? 48 : cs;
        int dci[8]; unsigned vmask = 0u;
#pragma unroll
        for (int e = 0; e < 8; ++e) { const int kc = kcs + (e >> 2) * 16 + 4 * g + (e & 3); int d = kc - qc + 15; d = d < 0 ? 0 : d; d = d > 30 ? 30 : d; dci[e] = d;
            if (kc >= cs && kc < cs + 16) vmask |= 1u << e; }
        bf16x8 qf[4][2];
#pragma unroll
        for (int j = 0; j < 4; ++j) { const bf16* qrow = Qh + (size_t)(seqbase + (r0 + j) * 64 + 16 * n + l15) * 64 + 8 * g; qf[j][0] = *(const bf16x8*)qrow; qf[j][1] = *(const bf16x8*)(qrow + 32); }
        f32x4 o[4][4]; float mrun[4], lrun[4];
#pragma unroll
        for (int j = 0; j < 4; ++j) { mrun[j] = -3.0e38f; lrun[j] = 0.f;
#pragma unroll
            for (int dt = 0; dt < 4; ++dt) o[j][dt] = (f32x4){0.f, 0.f, 0.f, 0.f}; }
        const int kr_lo = na_rs(r0, rows), kr_hi = na_rs(r0 + 3, rows) + 7;
        bf16x8 kn[2][2]; v4u vn[4];
        { const size_t tok0 = (size_t)(seqbase + kr_lo * 64 + kcs);
#pragma unroll
          for (int th = 0; th < 2; ++th) { const bf16* krow = Kh + (tok0 + th * 16 + l15) * 64 + 8 * g; kn[th][0] = *(const bf16x8*)krow; kn[th][1] = *(const bf16x8*)(krow + 32); }
#pragma unroll
          for (int it = 0; it < 4; ++it) vn[it] = *(const v4u*)(Vh + tok0 * 64 + (it * 64 + lane) * 8); }
        for (int kr = kr_lo; kr <= kr_hi; ++kr) {
            bf16x8 kf[2][2];
#pragma unroll
            for (int th = 0; th < 2; ++th) { kf[th][0] = kn[th][0]; kf[th][1] = kn[th][1]; }
#pragma unroll
            for (int it = 0; it < 4; ++it) { const int piece = it * 64 + lane; *(LAS v4u*)(vs + (piece >> 3) * VSTRIDE + (piece & 7) * 16) = vn[it]; }
            { const int krn = (kr < kr_hi) ? kr + 1 : kr; const size_t tok0 = (size_t)(seqbase + krn * 64 + kcs);
#pragma unroll
              for (int th = 0; th < 2; ++th) { const bf16* krow = Kh + (tok0 + th * 16 + l15) * 64 + 8 * g; kn[th][0] = *(const bf16x8*)krow; kn[th][1] = *(const bf16x8*)(krow + 32); }
#pragma unroll
              for (int it = 0; it < 4; ++it) vn[it] = *(const v4u*)(Vh + tok0 * 64 + (it * 64 + lane) * 8); }
            LDS_WAIT(); asm volatile("" ::: "memory");
            bf16x8 vf[4];
#pragma unroll
            for (int dt = 0; dt < 4; ++dt) {
                const s16x4 lo = __builtin_bit_cast(s16x4, __builtin_amdgcn_ds_read_tr16_b64_v4i16((LAS s16x4*)(trp + 32 * dt)));
                const s16x4 hi = __builtin_bit_cast(s16x4, __builtin_amdgcn_ds_read_tr16_b64_v4i16((LAS s16x4*)(trp + 32 * dt + 16 * VSTRIDE)));
                vf[dt] = (bf16x8){lo[0], lo[1], lo[2], lo[3], hi[0], hi[1], hi[2], hi[3]};
            }
            LDS_WAIT(); asm volatile("" ::: "memory");
#pragma unroll
            for (int j = 0; j < 4; ++j) {
                const int r = r0 + j, rsj = na_rs(r, rows);
                if (kr >= rsj && kr <= rsj + 7) {
                    f32x4 z = {0.f, 0.f, 0.f, 0.f};
                    f32x4 s0 = __builtin_amdgcn_mfma_f32_16x16x32_bf16(kf[0][0], qf[j][0], z, 0, 0, 0); s0 = __builtin_amdgcn_mfma_f32_16x16x32_bf16(kf[0][1], qf[j][1], s0, 0, 0, 0);
                    f32x4 s1 = __builtin_amdgcn_mfma_f32_16x16x32_bf16(kf[1][0], qf[j][0], z, 0, 0, 0); s1 = __builtin_amdgcn_mfma_f32_16x16x32_bf16(kf[1][1], qf[j][1], s1, 0, 0, 0);
                    const LAS float* brow = rph + (kr - r + 7) * 31;
                    float v[8]; float cmax = -3.0e38f;
#pragma unroll
                    for (int e = 0; e < 8; ++e) { const float sc = (e < 4 ? s0[e & 3] : s1[e & 3]) * C2 + brow[dci[e]]; v[e] = ((vmask >> e) & 1u) ? sc : -3.0e38f; cmax = fmaxf(cmax, v[e]); }
                    cmax = fmaxf(cmax, __shfl_xor(cmax, 16)); cmax = fmaxf(cmax, __shfl_xor(cmax, 32));
                    const float mnew = fmaxf(mrun[j], cmax), alpha = __builtin_amdgcn_exp2f(mrun[j] - mnew); mrun[j] = mnew;
                    float ps = 0.f;
#pragma unroll
                    for (int e = 0; e < 8; ++e) { v[e] = __builtin_amdgcn_exp2f(v[e] - mnew); ps += v[e]; }
                    lrun[j] = lrun[j] * alpha + ps;
                    const v4u pw = {pg8::cvt_pk_bf16(v[0], v[1]), pg8::cvt_pk_bf16(v[2], v[3]), pg8::cvt_pk_bf16(v[4], v[5]), pg8::cvt_pk_bf16(v[6], v[7])};
                    const bf16x8 pf = __builtin_bit_cast(bf16x8, pw);
#pragma unroll
                    for (int dt = 0; dt < 4; ++dt) o[j][dt] = __builtin_amdgcn_mfma_f32_16x16x32_bf16(vf[dt], pf, o[j][dt] * alpha, 0, 0, 0);
                }
            }
        }
#pragma unroll
        for (int j = 0; j < 4; ++j) {
            float l = lrun[j]; l += __shfl_xor(l, 16); l += __shfl_xor(l, 32);
            const float inv = 1.0f / l;
            bf16* orow = ATTN + (size_t)(seqbase + (r0 + j) * 64 + 16 * n + l15) * NAW + h * 64 + 4 * g;
#pragma unroll
            for (int dt = 0; dt < 4; ++dt) { v2u w; w.x = pg8::cvt_pk_bf16(o[j][dt][0] * inv, o[j][dt][1] * inv); w.y = pg8::cvt_pk_bf16(o[j][dt][2] * inv, o[j][dt][3] * inv); *(v2u*)(orow + 16 * dt) = w; }
        }
    }
}

__device__ __forceinline__ void p8_final(float* out, const float* SS2, const float* gf, int gw, int NGW, int lane) {
    f32x4 gv[4];
#pragma unroll
    for (int j = 0; j < 4; ++j) gv[j] = ((const f32x4*)gf)[lane + 64 * j];
    for (int m = gw; m < M; m += NGW) {
        const float rstd = 1.0f / sqrtf(SS2[m] * (1.f / D) + RMS_EPS);
        f32x4* yr = (f32x4*)(out + (size_t)m * D) + lane;
        f32x4 v[4];
#pragma unroll
        for (int j = 0; j < 4; ++j) v[j] = yr[64 * j];
#pragma unroll
        for (int j = 0; j < 4; ++j) yr[64 * j] = v[j] * rstd * gv[j];
    }
}

__global__ void __launch_bounds__(NWAVES * 64, 2) fwd_megakernel(Args args) {
    extern __shared__ __attribute__((aligned(16))) unsigned char lds_raw[];
    cg::grid_group grid = cg::this_grid();
    LAS unsigned char* lds = (LAS unsigned char*)lds_raw;
    const int tid = threadIdx.x, lane = tid & 63, wave = __builtin_amdgcn_readfirstlane(tid >> 6);
    const int G = gridDim.x, blk = blockIdx.x;
    const int gw = blk * NWAVES + wave, NGW = G * NWAVES;
    unsigned char* ws = args.ws;
    bf16* XN = (bf16*)(ws + WS_XN); bf16* ZP = (bf16*)(ws + WS_ZP); bf16* QH = (bf16*)(ws + WS_QH); bf16* GT = (bf16*)(ws + WS_GT);
    bf16* POOLED = (bf16*)(ws + WS_POOLED); bf16* ATTN = (bf16*)(ws + WS_ATTN); bf16* MIX = (bf16*)(ws + WS_ZP);
    bf16* X1G = (bf16*)(ws + WS_XN); bf16* HID = (bf16*)(ws + WS_HID);
    float* SS1 = (float*)(ws + WS_SS1); float* SS2 = (float*)(ws + WS_SS2);

    p0_prologue(args, lds, gw, NGW, wave, lane);
    grid.sync();
    { pg8::Gemm g{XN, (const bf16*)(ws + WS_WIN), M, NZ, D}; pg8::StaticOrder S; S.init(M, NZ, G, blk);
      pg8::EpiZ E{ZP, QH, GT, args.in[4]};
      pg8::gemm_phase<pg8::EpiZ, pg8::StaticOrder, true, true>(lds, g, S, E); }
    grid.sync();
    p2_pool(ZP, POOLED, gw, NGW, lane);
    p2_natten(QH, QH + (size_t)M * 512, QH + (size_t)M * 1024, ATTN, args.in[8], lds, blk, G, tid, wave, lane);
    grid.sync();
    { pg8::Gemm g{POOLED, (const bf16*)(ws + WS_WPP), M, D, PW}; pg8::StaticOrder S; S.init(M, D, G, blk);
      pg8::EpiMix<false> E{MIX, GT, 0};
      pg8::gemm_phase<pg8::EpiMix<false>, pg8::StaticOrder, true, true>(lds, g, S, E); }
    grid.sync();
    { pg8::Gemm g{ATTN, (const bf16*)(ws + WS_WNA), M, D, NAW}; pg8::StaticOrder S; S.init(M, D, G, blk);
      pg8::EpiMix<true> E{MIX, GT, 1024};
      pg8::gemm_phase<pg8::EpiMix<true>, pg8::StaticOrder, true, true>(lds, g, S, E); }
    grid.sync();
    { pg8::Gemm g{MIX, (const bf16*)(ws + WS_WOUT), M, D, D}; pg8::StaticOrder S; S.init(M, D, G, blk);
      pg8::EpiRes<false> E{args.in[0], args.in[1], MP, args.out, X1G, args.in[11], SS1};
      pg8::gemm_phase<pg8::EpiRes<false>, pg8::StaticOrder, true, true>(lds, g, S, E); }
    grid.sync();
    { pg8::Gemm g{X1G, (const bf16*)(ws + WS_WFF1), M, FF, D}; pg8::StaticOrder S; S.init(M, FF, G, blk);
      pg8::EpiHid E{HID, SS1, RMS_EPS};
      pg8::gemm_phase<pg8::EpiHid, pg8::StaticOrder, true, true>(lds, g, S, E); }
    grid.sync();
    { pg8::Gemm g{HID, (const bf16*)(ws + WS_WFF2), M, D, FF}; pg8::StaticOrder S; S.init(M, D, G, blk);
      pg8::EpiRes<true> E{args.out, args.out, M, args.out, nullptr, nullptr, SS2};
      pg8::gemm_phase<pg8::EpiRes<true>, pg8::StaticOrder, true, true>(lds, g, S, E); }
    grid.sync();
    p8_final(args.out, SS2, args.in[14], gw, NGW, lane);
}

extern "C" void kernel_launch(void* const* d_in, const int* in_sizes, int n_in, void* d_out, int out_size, void* d_ws, size_t ws_size, hipStream_t stream) {
    static int grid_blocks = 0;
    if (!grid_blocks) {
        if (n_in != 15 || out_size != M * D || ws_size < WS_END) { fprintf(stderr, "kernel_launch: unexpected shapes (n_in %d out %d ws %zu)\n", n_in, out_size, ws_size); grid_blocks = -1; return; }
        int dev = 0, cus = 0, per_cu = 0;
        (void)hipGetDevice(&dev);
        (void)hipDeviceGetAttribute(&cus, hipDeviceAttributeMultiprocessorCount, dev);
        (void)hipFuncSetAttribute((const void*)fwd_megakernel, hipFuncAttributeMaxDynamicSharedMemorySize, LDS_BYTES);
        (void)hipOccupancyMaxActiveBlocksPerMultiprocessor(&per_cu, (const void*)fwd_megakernel, NWAVES * 64, LDS_BYTES);
        if (per_cu < 1) per_cu = 1;
        grid_blocks = cus * per_cu;
    }
    if (grid_blocks < 0) return;
    Args a{};
    for (int i = 0; i < 15; ++i) a.in[i] = (const float*)d_in[i];
    a.out = (float*)d_out; a.ws = (unsigned char*)d_ws;
    void* kargs[] = {&a};
    hipError_t e = hipLaunchCooperativeKernel((const void*)fwd_megakernel, dim3(grid_blocks), dim3(NWAVES * 64), kargs, LDS_BYTES, stream);
    if (e != hipSuccess) fprintf(stderr, "cooperative launch failed: %s (grid %d)\n", hipGetErrorString(e), grid_blocks);
}
```

```cpp
#include <hip/hip_runtime.h>
#include <hip/hip_cooperative_groups.h>
#include <cstdio>
#include <cstdint>
namespace cg = cooperative_groups;
namespace pg8 {
#define PG8_LAS __attribute__((address_space(3)))
typedef unsigned short bf16_t;
typedef short bf16x8 __attribute__((ext_vector_type(8)));
typedef float f32x4 __attribute__((ext_vector_type(4)));
typedef unsigned u32x4 __attribute__((ext_vector_type(4)));
constexpr int BM = 256, BK = 64, HALF = 128, HTB = HALF * BK * 2  , STAGE_BYTES = 8 * HTB, NXCD = 8, WGM = 8;

__host__ __device__ __forceinline__ int lds_byte(int r, int c) { const int st = (r >> 4) * 2 + (c >> 5), rr = r & 15, cc = c & 31, ob = rr * 64 + cc * 2; return st * 1024 + (ob ^ (((ob >> 9) & 1) << 5)); }
__host__ __device__ __forceinline__ void stage_rc(int b, int& R, int& C) { const int st = b / 1024, sb = b % 1024, swz = sb ^ (((sb >> 9) & 1) << 5); R = (st >> 1) * 16 + swz / 64; C = (st & 1) * 32 + (swz % 64) / 2; }
__host__ __device__ __forceinline__ int perm32(int rho) { const int n = rho >> 4, i = rho & 15; return 8 * (i >> 2) + 4 * n + (i & 3); }

struct Unit { int pm, pn; };
struct Gemm { const bf16_t* A; const bf16_t* Bt; int M, N, K; };

struct StaticOrder {
    int nM, nN, nwg, G, c;
    __host__ __device__ void init(int M, int N, int G_, int c_) { nM = M / BM; nN = N / BM; nwg = nM * nN; G = G_; c = c_; }
    __host__ __device__ bool next(int i, Unit& u) const {
        const long L = (long)i * G + c; if (L >= nwg) return false;
        int wgid = (int)L; { const int q = nwg / NXCD, r = nwg % NXCD, xcd = wgid % NXCD, off = wgid / NXCD; wgid = (xcd < r ? xcd * (q + 1) : r * (q + 1) + (xcd - r) * q) + off; }
        const int nig = WGM * nN, gid = wgid / nig, fm = gid * WGM, gsz = (nM - fm) < WGM ? (nM - fm) : WGM;
        u.pm = fm + ((wgid % nig) % gsz); u.pn = (wgid % nig) / gsz; return true;
    }
    __device__ __forceinline__ void a_ready(const Unit&) const {}
    __device__ __forceinline__ void done(const Unit&) const {}
};

__device__ __forceinline__ unsigned cvt_pk_bf16(float lo, float hi) { unsigned r; asm volatile("v_cvt_pk_bf16_f32 %0, %1, %2" : "=v"(r) : "v"(lo), "v"(hi)); return r; }
typedef float f32x2 __attribute__((ext_vector_type(2)));
__device__ __forceinline__ float bf_lo(unsigned w) { return __uint_as_float(w << 16); }
__device__ __forceinline__ float bf_hi(unsigned w) { return __uint_as_float(w & 0xffff0000u); }
__device__ __forceinline__ float sigmoidf_fast(float x) { return __builtin_amdgcn_rcpf(1.0f + __builtin_amdgcn_exp2f(-1.4426950408889634f * x)); }
__device__ __forceinline__ u32x4 pack8(const f32x4 v0, const f32x4 v1) { u32x4 w; w.x = cvt_pk_bf16(v0[0], v0[1]); w.y = cvt_pk_bf16(v0[2], v0[3]); w.z = cvt_pk_bf16(v1[0], v1[1]); w.w = cvt_pk_bf16(v1[2], v1[3]); return w; }
__device__ __forceinline__ void unpack8(const u32x4 w, f32x4& v0, f32x4& v1) { v0 = (f32x4){bf_lo(w.x), bf_hi(w.x), bf_lo(w.y), bf_hi(w.y)}; v1 = (f32x4){bf_lo(w.z), bf_hi(w.z), bf_lo(w.w), bf_hi(w.w)}; }

struct EpiZ {
    static constexpr bool PERM = true, AFTER_DRAIN = false;
    bf16_t* PB; bf16_t* QKV; bf16_t* GT; const float* bgate;
    __device__ __forceinline__ void operator()(f32x4 (&acc)[2][2][4][2], const Unit& u, int wr, int wc, int fr, int fq) const {
        constexpr size_t MTOK = 81920;
        const int row0 = u.pm * BM + wr * 64 + fr; const bool gate = u.pn >= 8;
        f32x4 bv[2][2];
        const int gcol0 = (u.pn & 7) * BM + wc * 32 + 8 * fq;
#pragma unroll
        for (int bj = 0; bj < 2; ++bj)
#pragma unroll
            for (int n = 0; n < 2; ++n) bv[bj][n] = gate ? *(const f32x4*)(bgate + gcol0 + bj * HALF + 4 * n) : (f32x4){0.f, 0.f, 0.f, 0.f};
        bf16_t* base; size_t rstride, bjstep;
        if (gate) { base = GT + gcol0; rstride = 2048; bjstep = HALF; }
        else if (u.pn < 2) { base = PB + u.pn * BM + wc * 32 + 8 * fq; rstride = 512; bjstep = HALF; }
        else { const int which = (u.pn - 2) >> 1, cw = ((u.pn - 2) & 1) * BM + wc * 32 + 8 * fq;
            base = QKV + (size_t)which * MTOK * 512 + (size_t)(cw >> 6) * MTOK * 64 + (cw & 63); rstride = 64; bjstep = 2 * MTOK * 64; }
#pragma unroll
        for (int ai = 0; ai < 2; ++ai)
#pragma unroll
            for (int m = 0; m < 4; ++m) { bf16_t* rowp = base + (size_t)(row0 + ai * HALF + m * 16) * rstride;
#pragma unroll
                for (int bj = 0; bj < 2; ++bj) { f32x4 v0 = acc[ai][bj][m][0], v1 = acc[ai][bj][m][1];
                    if (gate) { v0 += bv[bj][0]; v1 += bv[bj][1];
#pragma unroll
                        for (int e = 0; e < 4; ++e) { v0[e] = sigmoidf_fast(v0[e]); v1[e] = sigmoidf_fast(v1[e]); } }
                    *(u32x4*)(rowp + bj * bjstep) = pack8(v0, v1); } }
    }
};
struct EpiMix {
    static constexpr bool PERM = true, AFTER_DRAIN = false;
    bf16_t* MIX; const bf16_t* GT;
    __device__ __forceinline__ void operator()(f32x4 (&acc)[2][2][4][2], const Unit& u, int wr, int wc, int fr, int fq) const {
        const bool add = u.pm >= 320; const int pm = add ? u.pm - 320 : u.pm, pn = u.pn & 3, gcol0 = add ? 1024 : 0;
        const int row0 = pm * BM + wr * 64 + fr; const int col0 = pn * BM + wc * 32 + 8 * fq;
#pragma unroll
        for (int ai = 0; ai < 2; ++ai)
#pragma unroll
            for (int m = 0; m < 4; ++m) { const size_t row = (size_t)(row0 + ai * HALF + m * 16);
#pragma unroll
                for (int bj = 0; bj < 2; ++bj) {
                    const u32x4 gw = *(const u32x4*)(GT + row * 2048 + gcol0 + col0 + bj * HALF);
                    f32x4 g0, g1; unpack8(gw, g0, g1);
                    f32x4 v0 = acc[ai][bj][m][0] * g0, v1 = acc[ai][bj][m][1] * g1;
                    bf16_t* op = MIX + row * 1024 + col0 + bj * HALF;
                    if (add) { const u32x4 ow = *(const u32x4*)op; f32x4 o0, o1; unpack8(ow, o0, o1); v0 += o0; v1 += o1; }
                    *(u32x4*)op = pack8(v0, v1); } }
    }
};
struct PairOrder {
    StaticOrder base; int dpm, dpn;
    __host__ __device__ bool next(int i, Unit& u) const { if (!base.next(i >> 1, u)) return false; if (i & 1) { u.pm += dpm; u.pn += dpn; } return true; }
    __device__ __forceinline__ void a_ready(const Unit&) const {}
    __device__ __forceinline__ void done(const Unit&) const {}
};
template <bool FINAL> struct EpiRes {
    static constexpr bool PERM = true, AFTER_DRAIN = false;
    const float* xa; const float* xb; int msplit;
    float* X1; bf16_t* X1G; const float* gmlp; float* SS;
    __device__ __forceinline__ void operator()(f32x4 (&acc)[2][2][4][2], const Unit& u, int wr, int wc, int fr, int fq) const {
        const int row0 = u.pm * BM + wr * 64 + fr; const int col0 = u.pn * BM + wc * 32 + 8 * fq;
        const float* xs = (u.pm * BM < msplit) ? xa : xb - (size_t)msplit * 1024;
        f32x4 gv[2][2];
        if (!FINAL) {
#pragma unroll
            for (int bj = 0; bj < 2; ++bj)
#pragma unroll
                for (int n = 0; n < 2; ++n) gv[bj][n] = *(const f32x4*)(gmlp + col0 + bj * HALF + 4 * n);
        }
#pragma unroll
        for (int ai = 0; ai < 2; ++ai)
#pragma unroll
            for (int m = 0; m < 4; ++m) { const size_t row = (size_t)(row0 + ai * HALF + m * 16); float ss = 0.f;
#pragma unroll
                for (int bj = 0; bj < 2; ++bj) { const size_t off = row * 1024 + col0 + bj * HALF;
                    const f32x4 x0 = *(const f32x4*)(xs + off), x1 = *(const f32x4*)(xs + off + 4);
                    const f32x4 v0 = acc[ai][bj][m][0] + x0, v1 = acc[ai][bj][m][1] + x1;
                    *(f32x4*)(X1 + off) = v0; *(f32x4*)(X1 + off + 4) = v1;
                    ss += (v0[0] * v0[0] + v0[1] * v0[1]) + (v0[2] * v0[2] + v0[3] * v0[3]) + (v1[0] * v1[0] + v1[1] * v1[1]) + (v1[2] * v1[2] + v1[3] * v1[3]);
                    if (!FINAL) *(u32x4*)(X1G + off) = pack8(v0 * gv[bj][0], v1 * gv[bj][1]); }
                ss += __shfl_xor(ss, 16); ss += __shfl_xor(ss, 32);
                if (fq == 0) atomicAdd(SS + row, ss); }
    }
};
struct EpiHid {
    static constexpr bool PERM = true, AFTER_DRAIN = false;
    bf16_t* HID; const float* SS; float eps;
    __device__ __forceinline__ void operator()(f32x4 (&acc)[2][2][4][2], const Unit& u, int wr, int wc, int fr, int fq) const {
        const int row0 = u.pm * BM + wr * 64 + fr; const int col0 = u.pn * BM + wc * 32 + 8 * fq;
#pragma unroll
        for (int ai = 0; ai < 2; ++ai)
#pragma unroll
            for (int m = 0; m < 4; ++m) { const size_t row = (size_t)(row0 + ai * HALF + m * 16);
                const float rs = __builtin_amdgcn_rsqf(SS[row] * (1.0f / 1024.0f) + eps);
#pragma unroll
                for (int bj = 0; bj < 2; ++bj) { f32x4 v0 = acc[ai][bj][m][0] * rs, v1 = acc[ai][bj][m][1] * rs;
#pragma unroll
                    for (int e = 0; e < 4; ++e) { const float a = fmaxf(v0[e], 0.f), b = fmaxf(v1[e], 0.f); v0[e] = a * a; v1[e] = b * b; }
                    *(u32x4*)(HID + row * 4096 + col0 + bj * HALF) = pack8(v0, v1); } }
    }
};

struct EpiFinal {
    static constexpr bool PERM = true, AFTER_DRAIN = false;
    float* OUT; float* SS; unsigned* CNT; const float* gfin; float eps;
    __device__ __forceinline__ void operator()(f32x4 (&acc)[2][2][4][2], const Unit& u, int wr, int wc, int fr, int fq) const {
        const int row0 = u.pm * BM + wr * 64 + fr; const int col0 = u.pn * BM + wc * 32 + 8 * fq;
#pragma unroll
        for (int ai = 0; ai < 2; ++ai)
#pragma unroll
            for (int m = 0; m < 4; ++m) { const size_t row = (size_t)(row0 + ai * HALF + m * 16); float ss = 0.f;
#pragma unroll
                for (int bj = 0; bj < 2; ++bj) { const size_t off = row * 1024 + col0 + bj * HALF;
                    const f32x4 x0 = *(const f32x4*)(OUT + off), x1 = *(const f32x4*)(OUT + off + 4);
                    const f32x4 v0 = acc[ai][bj][m][0] + x0, v1 = acc[ai][bj][m][1] + x1;
                    acc[ai][bj][m][0] = v0; acc[ai][bj][m][1] = v1;
                    ss += (v0[0] * v0[0] + v0[1] * v0[1]) + (v0[2] * v0[2] + v0[3] * v0[3]) + (v1[0] * v1[0] + v1[1] * v1[1]) + (v1[2] * v1[2] + v1[3] * v1[3]); }
                ss += __shfl_xor(ss, 16); ss += __shfl_xor(ss, 32);
                if (fq == 0) atomicAdd(SS + row, ss); }
        asm volatile("s_waitcnt vmcnt(0)" ::: "memory");
        unsigned* cnt = CNT + 64 * u.pm;
        if ((fr | fq) == 0) __hip_atomic_fetch_add(cnt, 1u, __ATOMIC_RELAXED, __HIP_MEMORY_SCOPE_AGENT);
        while (__hip_atomic_load(cnt, __ATOMIC_RELAXED, __HIP_MEMORY_SCOPE_AGENT) < 32u) __builtin_amdgcn_s_sleep(2);
        asm volatile("" ::: "memory");
        f32x4 gv[2][2];
#pragma unroll
        for (int bj = 0; bj < 2; ++bj)
#pragma unroll
            for (int n = 0; n < 2; ++n) gv[bj][n] = *(const f32x4*)(gfin + col0 + bj * HALF + 4 * n);
#pragma unroll
        for (int ai = 0; ai < 2; ++ai)
#pragma unroll
            for (int m = 0; m < 4; ++m) { const size_t row = (size_t)(row0 + ai * HALF + m * 16);
                const float rs = 1.0f / sqrtf(__hip_atomic_load(SS + row, __ATOMIC_RELAXED, __HIP_MEMORY_SCOPE_AGENT) * (1.0f / 1024.0f) + eps);
#pragma unroll
                for (int bj = 0; bj < 2; ++bj) { const size_t off = row * 1024 + col0 + bj * HALF;
                    *(f32x4*)(OUT + off) = acc[ai][bj][m][0] * rs * gv[bj][0]; *(f32x4*)(OUT + off + 4) = acc[ai][bj][m][1] * rs * gv[bj][1]; } }
    }
};
template <class Epi, class Sched, bool ALIGN_EPI = false, bool SP2 = false>
__device__ __forceinline__ void gemm_phase(PG8_LAS unsigned char* lds, const Gemm g, const Sched& S, const Epi& E) {
    const int tid = threadIdx.x, wid = __builtin_amdgcn_readfirstlane(tid >> 6), lane = tid & 63, wr = wid >> 2, wc = wid & 3, fr = lane & 15, fq = lane >> 4;
    const int K = g.K, nt = K / BK;
    unsigned voffA[2], voffB[2];
#pragma unroll
    for (int i = 0; i < 2; ++i) { int R, C; stage_rc(tid * 16 + i * 8192, R, C); const int Rb = Epi::PERM ? ((R & ~31) + perm32(R & 31)) : R;
        voffA[i] = (unsigned)(R * K + C) * 2u; voffB[i] = (unsigned)(Rb * K + C) * 2u; }
    const size_t kstep = (size_t)(BK * 2);
    const size_t hstep = (size_t)HALF * K * 2;
    const size_t tstep = 2 * hstep;
    const unsigned ldsw = (unsigned)wid * 1024u;
    const int aoff = lds_byte(wr * 64 + fr, fq * 8), boff = lds_byte(wc * 32 + fr, fq * 8);
#define PG8_SA(b, h) (((b) * 2 + (h)) * HTB)
#define PG8_SB(b, h) ((4 + (b) * 2 + (h)) * HTB)
#define PG8_STAGE(bufoff, gbase, voff) do { _Pragma("unroll") for (int _i = 0; _i < 2; ++_i) \
        __builtin_amdgcn_global_load_lds((const unsigned*)((const char*)(gbase) + (voff)[_i]), (PG8_LAS unsigned*)(lds + (bufoff) + ldsw + _i * 8192), 16, 0, 0); } while (0)
#define PG8_LDA(dst, b, h) do { _Pragma("unroll") for (int m = 0; m < 4; ++m) _Pragma("unroll") for (int k = 0; k < 2; ++k) dst[m][k] = *(const PG8_LAS bf16x8*)(lds + PG8_SA(b, h) + aoff + m * 2048 + k * 1024); } while (0)
#define PG8_LDB(dst, b, h) do { _Pragma("unroll") for (int n = 0; n < 2; ++n) _Pragma("unroll") for (int k = 0; k < 2; ++k) dst[n][k] = *(const PG8_LAS bf16x8*)(lds + PG8_SB(b, h) + boff + n * 2048 + k * 1024); } while (0)
#define PG8_MMA(ai, bj, At, Bt) do { __builtin_amdgcn_s_setprio(1); _Pragma("unroll") for (int m = 0; m < 4; ++m) _Pragma("unroll") for (int n = 0; n < 2; ++n) _Pragma("unroll") for (int k = 0; k < 2; ++k) \
        acc[ai][bj][m][n] = __builtin_amdgcn_mfma_f32_16x16x32_bf16(Bt[n][k], At[m][k], acc[ai][bj][m][n], 0, 0, 0); __builtin_amdgcn_s_setprio(0); } while (0)
#define PG8_WAIT_V(n) asm volatile("s_waitcnt vmcnt(" #n ")" ::: "memory")
#define PG8_WAIT_L(n) asm volatile("s_waitcnt lgkmcnt(" #n ")" ::: "memory")
#define PG8_BAR __builtin_amdgcn_s_barrier()
#define PG8_SCHED __builtin_amdgcn_sched_barrier(0)
    Unit cur, nxt; int ui = 0;
    if (!S.next(0, cur)) return;
    f32x4 acc[2][2][4][2];
#pragma unroll
    for (int a = 0; a < 2; ++a)
#pragma unroll
        for (int b = 0; b < 2; ++b)
#pragma unroll
            for (int m = 0; m < 4; ++m)
#pragma unroll
                for (int n = 0; n < 2; ++n) acc[a][b][m][n] = (f32x4){0.f, 0.f, 0.f, 0.f};
    bf16x8 At[4][2], B0[2][2], B1[2][2];
    const char* cA = (const char*)g.A + (size_t)cur.pm * tstep; const char* cB = (const char*)g.Bt + (size_t)cur.pn * tstep;
    S.a_ready(cur);
    if constexpr (SP2) {
        PG8_STAGE(PG8_SB(0, 0), cB, voffB); PG8_STAGE(PG8_SB(0, 1), cB + hstep, voffB); PG8_STAGE(PG8_SA(0, 0), cA, voffA); PG8_STAGE(PG8_SA(0, 1), cA + hstep, voffA);
        if (wr == 1) PG8_BAR;
        PG8_WAIT_V(2); PG8_BAR;
        PG8_STAGE(PG8_SB(1, 0), cB + kstep, voffB); PG8_STAGE(PG8_SA(1, 0), cA + kstep, voffA); PG8_STAGE(PG8_SB(1, 1), cB + hstep + kstep, voffB);
        PG8_WAIT_V(6); PG8_BAR;
    } else {
        PG8_STAGE(PG8_SB(0, 0), cB, voffB); PG8_STAGE(PG8_SA(0, 0), cA, voffA); PG8_STAGE(PG8_SB(0, 1), cB + hstep, voffB); PG8_STAGE(PG8_SA(0, 1), cA + hstep, voffA);
        if (wr == 1) PG8_BAR;
        PG8_WAIT_V(4); PG8_BAR;
        PG8_STAGE(PG8_SB(1, 0), cB + kstep, voffB); PG8_STAGE(PG8_SA(1, 0), cA + kstep, voffA); PG8_STAGE(PG8_SB(1, 1), cB + hstep + kstep, voffB);
        PG8_WAIT_V(6); PG8_BAR;
    }
    for (;;) {
        const bool has_next = S.next(ui + 1, nxt);
        const char* nA = has_next ? (const char*)g.A + (size_t)nxt.pm * tstep : cA; const char* nB = has_next ? (const char*)g.Bt + (size_t)nxt.pn * tstep : cB;
        for (int t = 0; t < nt; t += 2) {
            const bool last = (t == nt - 2);
            const char* a1 = cA + (size_t)(t + 1) * kstep;
            const char* a2 = last ? nA : cA + (size_t)(t + 2) * kstep; const char* b2 = last ? nB : cB + (size_t)(t + 2) * kstep;
            const char* a3 = a2 + kstep; const char* b3 = b2 + kstep;
            if (last && has_next) S.a_ready(nxt);
            if constexpr (SP2) {
            PG8_LDB(B0, 0, 0); PG8_LDB(B1, 0, 1); PG8_SCHED; PG8_LDA(At, 0, 0); PG8_STAGE(PG8_SA(1, 1), a1 + hstep, voffA);
            PG8_WAIT_V(8); PG8_WAIT_L(0); PG8_BAR; PG8_MMA(0, 0, At, B0); PG8_MMA(0, 1, At, B1); PG8_BAR; PG8_SCHED;
            PG8_LDA(At, 0, 1); PG8_STAGE(PG8_SB(0, 0), b2, voffB); PG8_STAGE(PG8_SB(0, 1), b2 + hstep, voffB); PG8_STAGE(PG8_SA(0, 0), a2, voffA);
            PG8_WAIT_V(8); PG8_WAIT_L(0); PG8_BAR; PG8_MMA(1, 0, At, B0); PG8_MMA(1, 1, At, B1); PG8_BAR; PG8_SCHED;
            PG8_LDB(B0, 1, 0); PG8_LDB(B1, 1, 1); PG8_SCHED; PG8_LDA(At, 1, 0); PG8_STAGE(PG8_SA(0, 1), a2 + hstep, voffA);
            PG8_WAIT_V(8); PG8_WAIT_L(0); PG8_BAR; PG8_MMA(0, 0, At, B0); PG8_MMA(0, 1, At, B1); PG8_BAR; PG8_SCHED;
            PG8_LDA(At, 1, 1); PG8_STAGE(PG8_SB(1, 0), b3, voffB); PG8_STAGE(PG8_SB(1, 1), b3 + hstep, voffB); PG8_STAGE(PG8_SA(1, 0), a3, voffA);
            PG8_WAIT_V(8); PG8_WAIT_L(0); PG8_BAR; PG8_MMA(1, 0, At, B0); PG8_MMA(1, 1, At, B1); PG8_BAR; PG8_SCHED;
            } else {
            PG8_LDB(B0, 0, 0); PG8_SCHED; PG8_LDA(At, 0, 0); PG8_STAGE(PG8_SA(1, 1), a1 + hstep, voffA);
            PG8_WAIT_L(8); PG8_BAR; PG8_WAIT_L(0); PG8_MMA(0, 0, At, B0); PG8_BAR; PG8_SCHED;
            PG8_LDB(B1, 0, 1); PG8_STAGE(PG8_SB(0, 0), b2, voffB);
            PG8_BAR; PG8_WAIT_L(0); PG8_MMA(0, 1, At, B1); PG8_BAR;
            PG8_LDA(At, 0, 1); PG8_STAGE(PG8_SA(0, 0), a2, voffA);
            PG8_BAR; PG8_WAIT_L(0); PG8_MMA(1, 0, At, B0); PG8_BAR; PG8_SCHED;
            PG8_STAGE(PG8_SB(0, 1), b2 + hstep, voffB);
            PG8_WAIT_V(6); PG8_BAR; PG8_MMA(1, 1, At, B1); PG8_BAR;
            PG8_LDB(B0, 1, 0); PG8_SCHED; PG8_LDA(At, 1, 0); PG8_STAGE(PG8_SA(0, 1), a2 + hstep, voffA);
            PG8_WAIT_L(8); PG8_BAR; PG8_WAIT_L(0); PG8_MMA(0, 0, At, B0); PG8_BAR; PG8_SCHED;
            PG8_LDB(B1, 1, 1); PG8_STAGE(PG8_SB(1, 0), b3, voffB);
            PG8_BAR; PG8_WAIT_L(0); PG8_MMA(0, 1, At, B1); PG8_BAR;
            PG8_LDA(At, 1, 1); PG8_STAGE(PG8_SA(1, 0), a3, voffA);
            PG8_BAR; PG8_WAIT_L(0); PG8_MMA(1, 0, At, B0); PG8_BAR; PG8_SCHED;
            PG8_STAGE(PG8_SB(1, 1), b3 + hstep, voffB);
            PG8_WAIT_V(6); PG8_BAR; PG8_MMA(1, 1, At, B1); PG8_BAR;
            }
        }
        if constexpr (ALIGN_EPI) { if (wr == 0) PG8_BAR; }
        if constexpr (!Epi::AFTER_DRAIN) { E(acc, cur, wr, wc, fr, fq); S.done(cur); }
        if (!has_next) break;
#pragma unroll
        for (int a = 0; a < 2; ++a)
#pragma unroll
            for (int b = 0; b < 2; ++b)
#pragma unroll
                for (int m = 0; m < 4; ++m)
#pragma unroll
                    for (int n = 0; n < 2; ++n) acc[a][b][m][n] = (f32x4){0.f, 0.f, 0.f, 0.f};
        cur = nxt; cA = nA; cB = nB; ++ui;
        if constexpr (ALIGN_EPI) { if (wr == 1) PG8_BAR; }
    }
    PG8_WAIT_V(0);
    if constexpr (!ALIGN_EPI) { if (wr == 0) PG8_BAR; }
    PG8_BAR;
    if constexpr (Epi::AFTER_DRAIN) { E.fused(acc, cur, wr, wc, fr, fq, lds, wid, lane); S.done(cur); }
#undef PG8_SA
#undef PG8_SB
#undef PG8_STAGE
#undef PG8_LDA
#undef PG8_LDB
#undef PG8_MMA
#undef PG8_WAIT_V
#undef PG8_WAIT_L
#undef PG8_BAR
#undef PG8_SCHED
}
}

constexpr int D = 1024, MP = 8 * 8192, MS = 8 * 2048, M = MP + MS, FF = 4096, NZ = 4096, PW = 512, NAW = 512;
constexpr float RMS_EPS = 1e-6f;
constexpr size_t MiB = 1u << 20;
constexpr size_t WS_WIN = 0, WS_WPP = 8 * MiB, WS_WNA = 9 * MiB, WS_WOUT = 10 * MiB, WS_WFF1 = 12 * MiB, WS_WFF2 = 20 * MiB;
constexpr size_t WS_SS1 = 28 * MiB, WS_SS2 = 29 * MiB, WS_CNT = 30 * MiB;
constexpr size_t WS_XN = 32 * MiB;
constexpr size_t WS_POOLED = WS_XN, WS_ATTN = WS_XN + (size_t)M * 512 * 2;
constexpr size_t WS_ZP = 192 * MiB;
constexpr size_t WS_QH = WS_ZP + (size_t)M * 512 * 2;
constexpr size_t WS_GT = 512 * MiB;
constexpr size_t WS_HID = WS_ZP;
constexpr size_t WS_END = 832 * MiB;
static_assert(WS_XN + (size_t)M * 1024 * 2 <= WS_ZP && WS_ZP + (size_t)M * 2048 * 2 <= WS_GT && WS_GT + (size_t)M * 2048 * 2 <= WS_END && WS_HID + (size_t)M * 4096 * 2 <= WS_END, "ws map");

constexpr int NWAVES = 8, LDS_BYTES = 147456;
#define LAS __attribute__((address_space(3)))
typedef unsigned short bf16;
typedef unsigned v4u __attribute__((ext_vector_type(4)));
typedef unsigned v2u __attribute__((ext_vector_type(2)));
typedef float f32x4 __attribute__((ext_vector_type(4)));
typedef short bf16x8 __attribute__((ext_vector_type(8)));
typedef short s16x4 __attribute__((ext_vector_type(4)));
#define LDS_WAIT() asm volatile("s_waitcnt lgkmcnt(0)" ::: "memory")
__device__ __forceinline__ unsigned f2bf(float f) { unsigned u = __builtin_bit_cast(unsigned, f); return (u + 0x7fffu + ((u >> 16) & 1u)) >> 16; }
__device__ __forceinline__ unsigned pk2(float lo, float hi) { return f2bf(lo) | (f2bf(hi) << 16); }
__device__ __forceinline__ float wave_sum(float v) {
#pragma unroll
    for (int o = 1; o < 64; o <<= 1) v += __shfl_xor(v, o);
    return v;
}

struct Args { const float* in[15]; float* out; unsigned char* ws; };

__device__ __forceinline__ void p0_transpose_item(const float* W, int K, int N, bf16* WT, LAS float* scr, int item, int lane) {
    const int nblk = N / 32, kb = item / nblk, nb = item % nblk, k0 = 64 * kb, n0 = 32 * nb;
#pragma unroll 8
    for (int i = 0; i < 32; ++i) { const int kk = 2 * i + (lane >> 5); scr[kk * 33 + (lane & 31)] = W[(size_t)(k0 + kk) * N + n0 + (lane & 31)]; }
    LDS_WAIT(); asm volatile("" ::: "memory");
    const int c = lane & 7;
#pragma unroll
    for (int j = 0; j < 4; ++j) { const int n = (lane >> 3) + 8 * j; const LAS float* s = scr + (8 * c) * 33 + n;
        v4u o; o.x = pk2(s[0 * 33], s[1 * 33]); o.y = pk2(s[2 * 33], s[3 * 33]); o.z = pk2(s[4 * 33], s[5 * 33]); o.w = pk2(s[6 * 33], s[7 * 33]);
        *(v4u*)(WT + (size_t)(n0 + n) * K + k0 + 8 * c) = o; }
    LDS_WAIT(); asm volatile("" ::: "memory");
}

__device__ __forceinline__ void p0_prologue(const Args& a, LAS unsigned char* lds, int gw, int NGW, int wave, int lane) {
    unsigned char* ws = a.ws;
    LAS float* scr = (LAS float*)(lds + wave * 16384);
    constexpr int I_IN = (D / 64) * (NZ / 32), I_NA = (NAW / 64) * (D / 32), I_OUT = (D / 64) * (D / 32), I_F1 = (D / 64) * (FF / 32), I_F2 = (FF / 64) * (D / 32);
    constexpr int NITEMS = I_IN + I_NA + I_OUT + I_F1 + I_F2;
    for (int it = gw; it < NITEMS; it += NGW) {
        int r = it;
        if (r < I_IN) { p0_transpose_item(a.in[3], D, NZ, (bf16*)(ws + WS_WIN), scr, r, lane); continue; } r -= I_IN;
        if (r < I_NA) { p0_transpose_item(a.in[9], NAW, D, (bf16*)(ws + WS_WNA), scr, r, lane); continue; } r -= I_NA;
        if (r < I_OUT) { p0_transpose_item(a.in[10], D, D, (bf16*)(ws + WS_WOUT), scr, r, lane); continue; } r -= I_OUT;
        if (r < I_F1) { p0_transpose_item(a.in[12], D, FF, (bf16*)(ws + WS_WFF1), scr, r, lane); continue; } r -= I_F1;
        p0_transpose_item(a.in[13], FF, D, (bf16*)(ws + WS_WFF2), scr, r, lane);
    }
    {
        const float* wg = a.in[5]; const float* sc = a.in[6]; const float* wp = a.in[7]; bf16* WPP = (bf16*)(ws + WS_WPP);
        for (int it = NGW - 1 - gw; it < 64 * 16; it += NGW) {
            const int cc = it >> 4, nb = it & 15, g = cc >> 4, c0 = (cc & 15) * 8, n = nb * 64 + lane;
            float acc[8];
#pragma unroll
            for (int j = 0; j < 8; ++j) acc[j] = 0.f;
            for (int d = 0; d < 128; ++d) {
                const float pv = wp[(size_t)(g * 128 + d) * D + n] * sc[g * 128 + d];
#pragma unroll
                for (int j = 0; j < 8; ++j) acc[j] += wg[(size_t)(g * 128 + c0 + j) * 128 + d] * pv;
            }
            v4u o; o.x = pk2(acc[0], acc[1]); o.y = pk2(acc[2], acc[3]); o.z = pk2(acc[4], acc[5]); o.w = pk2(acc[6], acc[7]);
            *(v4u*)(WPP + (size_t)n * PW + g * 128 + c0) = o;
        }
    }
    {
        float* ss1 = (float*)(ws + WS_SS1); float* ss2 = (float*)(ws + WS_SS2);
        for (int i = gw * 64 + lane; i < M; i += NGW * 64) { ss1[i] = 0.f; ss2[i] = 0.f; }
        unsigned* cnt = (unsigned*)(ws + WS_CNT);
        for (int i = gw * 64 + lane; i < 320 * 64; i += NGW * 64) cnt[i] = 0u;
    }
    {
        const float* gm = a.in[2]; bf16* XN = (bf16*)(ws + WS_XN);
        f32x4 gv[4];
#pragma unroll
        for (int j = 0; j < 4; ++j) gv[j] = ((const f32x4*)gm)[lane + 64 * j];
        for (int m = gw; m < M; m += NGW) {
            const float* xrow = (m < MP) ? a.in[0] + (size_t)m * D : a.in[1] + (size_t)(m - MP) * D;
            const f32x4* xr = (const f32x4*)xrow + lane;
            f32x4 v[4]; float s = 0.f;
#pragma unroll
            for (int j = 0; j < 4; ++j) { v[j] = xr[64 * j]; s += (v[j].x * v[j].x + v[j].y * v[j].y) + (v[j].z * v[j].z + v[j].w * v[j].w); }
            const float rstd = 1.0f / sqrtf(wave_sum(s) * (1.f / D) + RMS_EPS);
            unsigned long long* o8 = (unsigned long long*)(XN + (size_t)m * D) + lane;
#pragma unroll
            for (int j = 0; j < 4; ++j) { const f32x4 w = v[j] * rstd * gv[j]; o8[64 * j] = (unsigned long long)pk2(w.x, w.y) | ((unsigned long long)pk2(w.z, w.w) << 32); }
        }
    }
}

template <int HW> __device__ __forceinline__ void pool_chunk(const bf16* PB, bf16* POOLED, int m0, int t0, int S, int ch) {
    constexpr int NR = 8 + 2 * HW;
    v4u w[NR];
#pragma unroll
    for (int k = 0; k < NR; ++k) { const int tt = t0 - HW + k; w[k] = (v4u){0u, 0u, 0u, 0u};
        if (tt >= 0 && tt < S) w[k] = *(const v4u*)(PB + (size_t)(m0 - HW + k) * PW + ch); }
    float s[8];
#pragma unroll
    for (int e = 0; e < 8; ++e) s[e] = 0.f;
#pragma unroll
    for (int k = 0; k < 2 * HW; ++k) { s[0] += pg8::bf_lo(w[k].x); s[1] += pg8::bf_hi(w[k].x); s[2] += pg8::bf_lo(w[k].y); s[3] += pg8::bf_hi(w[k].y);
        s[4] += pg8::bf_lo(w[k].z); s[5] += pg8::bf_hi(w[k].z); s[6] += pg8::bf_lo(w[k].w); s[7] += pg8::bf_hi(w[k].w); }
#pragma unroll
    for (int i = 0; i < 8; ++i) {
        const int t = t0 + i; const int lo = (t - HW > 0) ? t - HW : 0, hi = (t + HW < S) ? t + HW : S;
        const float inv = 1.0f / (float)(hi - lo);
        const v4u sf = w[i + HW];
        v4u o; o.x = pk2(s[0] * inv - pg8::bf_lo(sf.x), s[1] * inv - pg8::bf_hi(sf.x)); o.y = pk2(s[2] * inv - pg8::bf_lo(sf.y), s[3] * inv - pg8::bf_hi(sf.y));
        o.z = pk2(s[4] * inv - pg8::bf_lo(sf.z), s[5] * inv - pg8::bf_hi(sf.z)); o.w = pk2(s[6] * inv - pg8::bf_lo(sf.w), s[7] * inv - pg8::bf_hi(sf.w));
        *(v4u*)(POOLED + (size_t)(m0 + i) * PW + ch) = o;
        if (i < 7) { const v4u a = w[i + 2 * HW], b = w[i];
            s[0] += pg8::bf_lo(a.x) - pg8::bf_lo(b.x); s[1] += pg8::bf_hi(a.x) - pg8::bf_hi(b.x); s[2] += pg8::bf_lo(a.y) - pg8::bf_lo(b.y); s[3] += pg8::bf_hi(a.y) - pg8::bf_hi(b.y);
            s[4] += pg8::bf_lo(a.z) - pg8::bf_lo(b.z); s[5] += pg8::bf_hi(a.z) - pg8::bf_hi(b.z); s[6] += pg8::bf_lo(a.w) - pg8::bf_lo(b.w); s[7] += pg8::bf_hi(a.w) - pg8::bf_hi(b.w); }
    }
}
__device__ __forceinline__ void p2_pool(const bf16* PB, bf16* POOLED, int gw, int NGW, int lane) {
    constexpr int NCH = (M / 32) * 4;
    for (int it = gw; it < NCH; it += NGW) {
        const int c32 = it >> 2, gq = (it + (it >> 11)) & 3;
        const int m0 = c32 * 32 + (lane >> 4) * 8, ch = gq * 128 + (lane & 15) * 8;
        int t0, S; if (m0 < MP) { t0 = m0 & 8191; S = 8192; } else { t0 = (m0 - MP) & 2047; S = 2048; }
        if (gq == 0) pool_chunk<1>(PB, POOLED, m0, t0, S, ch);
        else if (gq == 1) pool_chunk<2>(PB, POOLED, m0, t0, S, ch);
        else if (gq == 2) pool_chunk<4>(PB, POOLED, m0, t0, S, ch);
        else pool_chunk<8>(PB, POOLED, m0, t0, S, ch);
    }
}

constexpr int VSTRIDE = 160;
constexpr int VBUF_BYTES = 32 * VSTRIDE;
constexpr int RPB_OFF = 8 * VBUF_BYTES;
__device__ __forceinline__ int na_rs(int r, int rows) { int rs = r - 4; rs = rs < 0 ? 0 : rs; return rs > rows - 8 ? rows - 8 : rs; }
__device__ __forceinline__ void p2_natten(const bf16* QH, const bf16* KH, const bf16* VH, bf16* ATTN, const float* rpb, LAS unsigned char* lds, int blk, int G, int tid, int wave, int lane) {
    LAS float* rp = (LAS float*)(lds + RPB_OFF);
    for (int i = tid; i < 8 * 15 * 31; i += NWAVES * 64) rp[i] = rpb[i] * 1.4426950408889634f;
    __syncthreads();
    const int h = wave, l15 = lane & 15, g = lane >> 4;
    LAS unsigned char* vs = lds + wave * VBUF_BYTES;
    const LAS float* rph = rp + h * 15 * 31;
    const bf16* Qh = QH + (size_t)h * M * 64; const bf16* Kh = KH + (size_t)h * M * 64; const bf16* Vh = VH + (size_t)h * M * 64;
    constexpr int NUNITS = 8 * 4 * 32 + 8 * 4 * 8;
    const int per = (NUNITS + G - 1) / G;
    const int u0 = blk * per, u1 = (u0 + per < NUNITS) ? u0 + per : NUNITS;
    const float C2 = 0.125f * 1.4426950408889634f;
    const LAS unsigned char* trp = vs + (4 * g + (l15 >> 2)) * VSTRIDE + 8 * (l15 & 3);
    for (int u = u0; u < u1; ++u) {
        int seqbase, n, r0, rows;
        if (u < 1024) { seqbase = (u >> 7) * 8192; const int rem = u & 127; n = rem >> 5; r0 = (rem & 31) * 4; rows = 128; }
        else { const int v = u - 1024; seqbase = MP + (v >> 5) * 2048; const int rem = v & 31; n = rem >> 3; r0 = (rem & 7) * 4; rows = 32; }
        int kcs = 16 * n - 8; kcs = kcs < 0 ? 0 : kcs; kcs = kcs > 32 ? 32 : kcs;
        const int qc = 16 * n + l15; int cs = qc - 8; cs = cs < 0 ? 0 : cs; cs = cs > 48 ? 48 : cs;
        int dci[8]; unsigned vmask = 0u;
#pragma unroll
        for (int e = 0; e < 8; ++e) { const int kc = kcs + (e >> 2) * 16 + 4 * g + (e & 3); int d = kc - qc + 15; d = d < 0 ? 0 : d; d = d > 30 ? 30 : d; dci[e] = d;
            if (kc >= cs && kc < cs + 16) vmask |= 1u << e; }
        bf16x8 qf[4][2];
#pragma unroll
        for (int j = 0; j < 4; ++j) { const bf16* qrow = Qh + (size_t)(seqbase + (r0 + j) * 64 + 16 * n + l15) * 64 + 8 * g; qf[j][0] = *(const bf16x8*)qrow; qf[j][1] = *(const bf16x8*)(qrow + 32); }
        f32x4 o[4][4]; float mrun[4], lrun[4];
#pragma unroll
        for (int j = 0; j < 4; ++j) { mrun[j] = -3.0e38f; lrun[j] = 0.f;
#pragma unroll
            for (int dt = 0; dt < 4; ++dt) o[j][dt] = (f32x4){0.f, 0.f, 0.f, 0.f}; }
        const int kr_lo = na_rs(r0, rows), kr_hi = na_rs(r0 + 3, rows) + 7;
        bf16x8 kn[2][2]; v4u vn[4];
        { const size_t tok0 = (size_t)(seqbase + kr_lo * 64 + kcs);
#pragma unroll
          for (int th = 0; th < 2; ++th) { const bf16* krow = Kh + (tok0 + th * 16 + l15) * 64 + 8 * g; kn[th][0] = *(const bf16x8*)krow; kn[th][1] = *(const bf16x8*)(krow + 32); }
#pragma unroll
          for (int it = 0; it < 4; ++it) vn[it] = *(const v4u*)(Vh + tok0 * 64 + (it * 64 + lane) * 8); }
        for (int kr = kr_lo; kr <= kr_hi; ++kr) {
            bf16x8 kf[2][2];
#pragma unroll
            for (int th = 0; th < 2; ++th) { kf[th][0] = kn[th][0]; kf[th][1] = kn[th][1]; }
#pragma unroll
            for (int it = 0; it < 4; ++it) { const int piece = it * 64 + lane; *(LAS v4u*)(vs + (piece >> 3) * VSTRIDE + (piece & 7) * 16) = vn[it]; }
            { const int krn = (kr < kr_hi) ? kr + 1 : kr; const size_t tok0 = (size_t)(seqbase + krn * 64 + kcs);
#pragma unroll
              for (int th = 0; th < 2; ++th) { const bf16* krow = Kh + (tok0 + th * 16 + l15) * 64 + 8 * g; kn[th][0] = *(const bf16x8*)krow; kn[th][1] = *(const bf16x8*)(krow + 32); }
#pragma unroll
              for (int it = 0; it < 4; ++it) vn[it] = *(const v4u*)(Vh + tok0 * 64 + (it * 64 + lane) * 8); }
            LDS_WAIT(); asm volatile("" ::: "memory");
            bf16x8 vf[4];
#pragma unroll
            for (int dt = 0; dt < 4; ++dt) {
                const s16x4 lo = __builtin_bit_cast(s16x4, __builtin_amdgcn_ds_read_tr16_b64_v4i16((LAS s16x4*)(trp + 32 * dt)));
                const s16x4 hi = __builtin_bit_cast(s16x4, __builtin_amdgcn_ds_read_tr16_b64_v4i16((LAS s16x4*)(trp + 32 * dt + 16 * VSTRIDE)));
                vf[dt] = (bf16x8){lo[0], lo[1], lo[2], lo[3], hi[0], hi[1], hi[2], hi[3]};
            }
            LDS_WAIT(); asm volatile("" ::: "memory");
#pragma unroll
            for (int j = 0; j < 4; ++j) {
                const int r = r0 + j, rsj = na_rs(r, rows);
                if (kr >= rsj && kr <= rsj + 7) {
                    f32x4 z = {0.f, 0.f, 0.f, 0.f};
                    f32x4 s0 = __builtin_amdgcn_mfma_f32_16x16x32_bf16(kf[0][0], qf[j][0], z, 0, 0, 0); s0 = __builtin_amdgcn_mfma_f32_16x16x32_bf16(kf[0][1], qf[j][1], s0, 0, 0, 0);
                    f32x4 s1 = __builtin_amdgcn_mfma_f32_16x16x32_bf16(kf[1][0], qf[j][0], z, 0, 0, 0); s1 = __builtin_amdgcn_mfma_f32_16x16x32_bf16(kf[1][1], qf[j][1], s1, 0, 0, 0);
                    const LAS float* brow = rph + (kr - r + 7) * 31;
                    float v[8]; float cmax = -3.0e38f;
#pragma unroll
                    for (int e = 0; e < 8; ++e) { const float sc = (e < 4 ? s0[e & 3] : s1[e & 3]) * C2 + brow[dci[e]]; v[e] = ((vmask >> e) & 1u) ? sc : -3.0e38f; cmax = fmaxf(cmax, v[e]); }
                    cmax = fmaxf(cmax, __shfl_xor(cmax, 16)); cmax = fmaxf(cmax, __shfl_xor(cmax, 32));
                    const float mnew = fmaxf(mrun[j], cmax), alpha = __builtin_amdgcn_exp2f(mrun[j] - mnew); mrun[j] = mnew;
                    float ps = 0.f;
#pragma unroll
                    for (int e = 0; e < 8; ++e) { v[e] = __builtin_amdgcn_exp2f(v[e] - mnew); ps += v[e]; }
                    lrun[j] = lrun[j] * alpha + ps;
                    const v4u pw = {pg8::cvt_pk_bf16(v[0], v[1]), pg8::cvt_pk_bf16(v[2], v[3]), pg8::cvt_pk_bf16(v[4], v[5]), pg8::cvt_pk_bf16(v[6], v[7])};
                    const bf16x8 pf = __builtin_bit_cast(bf16x8, pw);
#pragma unroll
                    for (int dt = 0; dt < 4; ++dt) o[j][dt] = __builtin_amdgcn_mfma_f32_16x16x32_bf16(vf[dt], pf, o[j][dt] * alpha, 0, 0, 0);
                }
            }
        }
#pragma unroll
        for (int j = 0; j < 4; ++j) {
            float l = lrun[j]; l += __shfl_xor(l, 16); l += __shfl_xor(l, 32);
            const float inv = 1.0f / l;
            bf16* orow = ATTN + (size_t)(seqbase + (r0 + j) * 64 + 16 * n + l15) * NAW + h * 64 + 4 * g;
#pragma unroll
            for (int dt = 0; dt < 4; ++dt) { v2u w; w.x = pg8::cvt_pk_bf16(o[j][dt][0] * inv, o[j][dt][1] * inv); w.y = pg8::cvt_pk_bf16(o[j][dt][2] * inv, o[j][dt][3] * inv); *(v2u*)(orow + 16 * dt) = w; }
        }
    }
}

__device__ __forceinline__ void p8_final(float* out, const float* SS2, const float* gf, int gw, int NGW, int lane) {
    f32x4 gv[4];
#pragma unroll
    for (int j = 0; j < 4; ++j) gv[j] = ((const f32x4*)gf)[lane + 64 * j];
    for (int m = gw; m < M; m += NGW) {
        const float rstd = 1.0f / sqrtf(SS2[m] * (1.f / D) + RMS_EPS);
        f32x4* yr = (f32x4*)(out + (size_t)m * D) + lane;
        f32x4 v[4];
#pragma unroll
        for (int j = 0; j < 4; ++j) v[j] = yr[64 * j];
#pragma unroll
        for (int j = 0; j < 4; ++j) yr[64 * j] = v[j] * rstd * gv[j];
    }
}

__global__ void __launch_bounds__(NWAVES * 64, 2) fwd_megakernel(Args args) {
    extern __shared__ __attribute__((aligned(16))) unsigned char lds_raw[];
    cg::grid_group grid = cg::this_grid();
    LAS unsigned char* lds = (LAS unsigned char*)lds_raw;
    const int tid = threadIdx.x, lane = tid & 63, wave = __builtin_amdgcn_readfirstlane(tid >> 6);
    const int G = gridDim.x, blk = blockIdx.x;
    const int gw = blk * NWAVES + wave, NGW = G * NWAVES;
    unsigned char* ws = args.ws;
    bf16* XN = (bf16*)(ws + WS_XN); bf16* ZP = (bf16*)(ws + WS_ZP); bf16* QH = (bf16*)(ws + WS_QH); bf16* GT = (bf16*)(ws + WS_GT);
    bf16* POOLED = (bf16*)(ws + WS_POOLED); bf16* ATTN = (bf16*)(ws + WS_ATTN); bf16* MIX = (bf16*)(ws + WS_ZP);
    bf16* X1G = (bf16*)(ws + WS_XN); bf16* HID = (bf16*)(ws + WS_HID);
    float* SS1 = (float*)(ws + WS_SS1); float* SS2 = (float*)(ws + WS_SS2);

    p0_prologue(args, lds, gw, NGW, wave, lane);
    grid.sync();
    { pg8::Gemm g{XN, (const bf16*)(ws + WS_WIN), M, NZ, D}; pg8::StaticOrder S; S.init(M, NZ, G, blk);
      pg8::EpiZ E{ZP, QH, GT, args.in[4]};
      pg8::gemm_phase<pg8::EpiZ, pg8::StaticOrder, true, true>(lds, g, S, E); }
    grid.sync();
    p2_pool(ZP, POOLED, gw, NGW, lane);
    p2_natten(QH, QH + (size_t)M * 512, QH + (size_t)M * 1024, ATTN, args.in[8], lds, blk, G, tid, wave, lane);
    grid.sync();
    { pg8::Gemm g{POOLED, (const bf16*)(ws + WS_WPP), 2 * M, 2 * D, PW}; pg8::PairOrder S; S.base.init(M, D, G, blk); S.dpm = M / 256; S.dpn = D / 256;
      pg8::EpiMix E{MIX, GT};
      pg8::gemm_phase<pg8::EpiMix, pg8::PairOrder, true, true>(lds, g, S, E); }
    grid.sync();
    { pg8::Gemm g{MIX, (const bf16*)(ws + WS_WOUT), M, D, D}; pg8::StaticOrder S; S.init(M, D, G, blk);
      pg8::EpiRes<false> E{args.in[0], args.in[1], MP, args.out, X1G, args.in[11], SS1};
      pg8::gemm_phase<pg8::EpiRes<false>, pg8::StaticOrder, true, true>(lds, g, S, E); }
    grid.sync();
    { pg8::Gemm g{X1G, (const bf16*)(ws + WS_WFF1), M, FF, D}; pg8::StaticOrder S; S.init(M, FF, G, blk);
      pg8::EpiHid E{HID, SS1, RMS_EPS};
      pg8::gemm_phase<pg8::EpiHid, pg8::StaticOrder, true, true>(lds, g, S, E); }
    grid.sync();
    if (G == 256) {
      pg8::Gemm g{HID, (const bf16*)(ws + WS_WFF2), M, D, FF}; pg8::StaticOrder S; S.init(M, D, G, blk);
      pg8::EpiFinal E{args.out, SS2, (unsigned*)(ws + WS_CNT), args.in[14], RMS_EPS};
      pg8::gemm_phase<pg8::EpiFinal, pg8::StaticOrder, true, true>(lds, g, S, E);
    } else {
      { pg8::Gemm g{HID, (const bf16*)(ws + WS_WFF2), M, D, FF}; pg8::StaticOrder S; S.init(M, D, G, blk);
        pg8::EpiRes<true> E{args.out, args.out, M, args.out, nullptr, nullptr, SS2};
        pg8::gemm_phase<pg8::EpiRes<true>, pg8::StaticOrder, true, true>(lds, g, S, E); }
      grid.sync();
      p8_final(args.out, SS2, args.in[14], gw, NGW, lane);
    }
}

extern "C" void kernel_launch(void* const* d_in, const int* in_sizes, int n_in, void* d_out, int out_size, void* d_ws, size_t ws_size, hipStream_t stream) {
    static int grid_blocks = 0;
    if (!grid_blocks) {
        if (n_in != 15 || out_size != M * D || ws_size < WS_END) { fprintf(stderr, "kernel_launch: unexpected shapes (n_in %d out %d ws %zu)\n", n_in, out_size, ws_size); grid_blocks = -1; return; }
        int dev = 0, cus = 0, per_cu = 0;
        (void)hipGetDevice(&dev);
        (void)hipDeviceGetAttribute(&cus, hipDeviceAttributeMultiprocessorCount, dev);
        (void)hipFuncSetAttribute((const void*)fwd_megakernel, hipFuncAttributeMaxDynamicSharedMemorySize, LDS_BYTES);
        (void)hipOccupancyMaxActiveBlocksPerMultiprocessor(&per_cu, (const void*)fwd_megakernel, NWAVES * 64, LDS_BYTES);
        if (per_cu < 1) per_cu = 1;
        grid_blocks = cus * per_cu;
    }
    if (grid_blocks < 0) return;
    Args a{};
    for (int i = 0; i < 15; ++i) a.in[i] = (const float*)d_in[i];
    a.out = (float*)d_out; a.ws = (unsigned char*)d_ws;
    void* kargs[] = {&a};
    hipError_t e = hipLaunchCooperativeKernel((const void*)fwd_megakernel, dim3(grid_blocks), dim3(NWAVES * 64), kargs, LDS_BYTES, stream);
    if (e != hipSuccess) fprintf(stderr, "cooperative launch failed: %s (grid %d)\n", hipGetErrorString(e), grid_blocks);
}
```

```cpp
#include <hip/hip_runtime.h>
#include <hip/hip_cooperative_groups.h>
#include <cstdio>
#include <cstdint>
namespace cg = cooperative_groups;
namespace pg8 {
#define PG8_LAS __attribute__((address_space(3)))
typedef unsigned short bf16_t;
typedef short bf16x8 __attribute__((ext_vector_type(8)));
typedef float f32x4 __attribute__((ext_vector_type(4)));
typedef unsigned u32x4 __attribute__((ext_vector_type(4)));
constexpr int BM = 256, BK = 64, HALF = 128, HTB = HALF * BK * 2  , STAGE_BYTES = 8 * HTB, NXCD = 8, WGM = 8;

__host__ __device__ __forceinline__ int lds_byte(int r, int c) { const int st = (r >> 4) * 2 + (c >> 5), rr = r & 15, cc = c & 31, ob = rr * 64 + cc * 2; return st * 1024 + (ob ^ (((ob >> 9) & 1) << 5)); }
__host__ __device__ __forceinline__ void stage_rc(int b, int& R, int& C) { const int st = b / 1024, sb = b % 1024, swz = sb ^ (((sb >> 9) & 1) << 5); R = (st >> 1) * 16 + swz / 64; C = (st & 1) * 32 + (swz % 64) / 2; }
__host__ __device__ __forceinline__ int perm32(int rho) { const int n = rho >> 4, i = rho & 15; return 8 * (i >> 2) + 4 * n + (i & 3); }

struct Unit { int pm, pn; };
struct Gemm { const bf16_t* A; const bf16_t* Bt; int M, N, K; };

struct StaticOrder {
    int nM, nN, nwg, G, c;
    __host__ __device__ void init(int M, int N, int G_, int c_) { nM = M / BM; nN = N / BM; nwg = nM * nN; G = G_; c = c_; }
    __host__ __device__ bool next(int i, Unit& u) const {
        const long L = (long)i * G + c; if (L >= nwg) return false;
        int wgid = (int)L; { const int q = nwg / NXCD, r = nwg % NXCD, xcd = wgid % NXCD, off = wgid / NXCD; wgid = (xcd < r ? xcd * (q + 1) : r * (q + 1) + (xcd - r) * q) + off; }
        const int nig = WGM * nN, gid = wgid / nig, fm = gid * WGM, gsz = (nM - fm) < WGM ? (nM - fm) : WGM;
        u.pm = fm + ((wgid % nig) % gsz); u.pn = (wgid % nig) / gsz; return true;
    }
    __device__ __forceinline__ void a_ready(const Unit&) const {}
    __device__ __forceinline__ void done(const Unit&) const {}
};

__device__ __forceinline__ unsigned cvt_pk_bf16(float lo, float hi) { unsigned r; asm volatile("v_cvt_pk_bf16_f32 %0, %1, %2" : "=v"(r) : "v"(lo), "v"(hi)); return r; }
typedef float f32x2 __attribute__((ext_vector_type(2)));
__device__ __forceinline__ float bf_lo(unsigned w) { return __uint_as_float(w << 16); }
__device__ __forceinline__ float bf_hi(unsigned w) { return __uint_as_float(w & 0xffff0000u); }
__device__ __forceinline__ float sigmoidf_fast(float x) { return __builtin_amdgcn_rcpf(1.0f + __builtin_amdgcn_exp2f(-1.4426950408889634f * x)); }
__device__ __forceinline__ u32x4 pack8(const f32x4 v0, const f32x4 v1) { u32x4 w; w.x = cvt_pk_bf16(v0[0], v0[1]); w.y = cvt_pk_bf16(v0[2], v0[3]); w.z = cvt_pk_bf16(v1[0], v1[1]); w.w = cvt_pk_bf16(v1[2], v1[3]); return w; }
__device__ __forceinline__ void unpack8(const u32x4 w, f32x4& v0, f32x4& v1) { v0 = (f32x4){bf_lo(w.x), bf_hi(w.x), bf_lo(w.y), bf_hi(w.y)}; v1 = (f32x4){bf_lo(w.z), bf_hi(w.z), bf_lo(w.w), bf_hi(w.w)}; }

struct EpiZ {
    static constexpr bool PERM = true, AFTER_DRAIN = false;
    bf16_t* PB; bf16_t* QKV; bf16_t* GT; const float* bgate;
    __device__ __forceinline__ void operator()(f32x4 (&acc)[2][2][4][2], const Unit& u, int wr, int wc, int fr, int fq) const {
        constexpr size_t MTOK = 81920;
        const int row0 = u.pm * BM + wr * 64 + fr; const bool gate = u.pn >= 8;
        f32x4 bv[2][2];
        const int gcol0 = (u.pn & 7) * BM + wc * 32 + 8 * fq;
#pragma unroll
        for (int bj = 0; bj < 2; ++bj)
#pragma unroll
            for (int n = 0; n < 2; ++n) bv[bj][n] = gate ? *(const f32x4*)(bgate + gcol0 + bj * HALF + 4 * n) : (f32x4){0.f, 0.f, 0.f, 0.f};
        bf16_t* base; size_t rstride, bjstep;
        if (gate) { base = GT + gcol0; rstride = 2048; bjstep = HALF; }
        else if (u.pn < 2) { base = PB + u.pn * BM + wc * 32 + 8 * fq; rstride = 512; bjstep = HALF; }
        else { const int which = (u.pn - 2) >> 1, cw = ((u.pn - 2) & 1) * BM + wc * 32 + 8 * fq;
            base = QKV + (size_t)which * MTOK * 512 + (size_t)(cw >> 6) * MTOK * 64 + (cw & 63); rstride = 64; bjstep = 2 * MTOK * 64; }
#pragma unroll
        for (int ai = 0; ai < 2; ++ai)
#pragma unroll
            for (int m = 0; m < 4; ++m) { bf16_t* rowp = base + (size_t)(row0 + ai * HALF + m * 16) * rstride;
#pragma unroll
                for (int bj = 0; bj < 2; ++bj) { f32x4 v0 = acc[ai][bj][m][0], v1 = acc[ai][bj][m][1];
                    if (gate) { v0 += bv[bj][0]; v1 += bv[bj][1];
#pragma unroll
                        for (int e = 0; e < 4; ++e) { v0[e] = sigmoidf_fast(v0[e]); v1[e] = sigmoidf_fast(v1[e]); } }
                    *(u32x4*)(rowp + bj * bjstep) = pack8(v0, v1); } }
    }
};
struct EpiMix {
    static constexpr bool PERM = true, AFTER_DRAIN = false;
    bf16_t* MIX; const bf16_t* GT;
    __device__ __forceinline__ void operator()(f32x4 (&acc)[2][2][4][2], const Unit& u, int wr, int wc, int fr, int fq) const {
        const bool add = u.pm >= 320; const int pm = add ? u.pm - 320 : u.pm, pn = u.pn & 3, gcol0 = add ? 1024 : 0;
        const int row0 = pm * BM + wr * 64 + fr; const int col0 = pn * BM + wc * 32 + 8 * fq;
#pragma unroll
        for (int ai = 0; ai < 2; ++ai)
#pragma unroll
            for (int m = 0; m < 4; ++m) { const size_t row = (size_t)(row0 + ai * HALF + m * 16);
#pragma unroll
                for (int bj = 0; bj < 2; ++bj) {
                    const u32x4 gw = *(const u32x4*)(GT + row * 2048 + gcol0 + col0 + bj * HALF);
                    f32x4 g0, g1; unpack8(gw, g0, g1);
                    f32x4 v0 = acc[ai][bj][m][0] * g0, v1 = acc[ai][bj][m][1] * g1;
                    bf16_t* op = MIX + row * 1024 + col0 + bj * HALF;
                    if (add) { const u32x4 ow = *(const u32x4*)op; f32x4 o0, o1; unpack8(ow, o0, o1); v0 += o0; v1 += o1; }
                    *(u32x4*)op = pack8(v0, v1); } }
    }
};
struct PairOrder {
    StaticOrder base; int dpm, dpn;
    __host__ __device__ bool next(int i, Unit& u) const { if (!base.next(i >> 1, u)) return false; if (i & 1) { u.pm += dpm; u.pn += dpn; } return true; }
    __device__ __forceinline__ void a_ready(const Unit&) const {}
    __device__ __forceinline__ void done(const Unit&) const {}
};
struct EpiRes {
    static constexpr bool PERM = true, AFTER_DRAIN = false;
    const float* xa; const float* xb; int msplit;
    bf16_t* X1B; float* SS;
    __device__ __forceinline__ void operator()(f32x4 (&acc)[2][2][4][2], const Unit& u, int wr, int wc, int fr, int fq) const {
        const int row0 = u.pm * BM + wr * 64 + fr; const int col0 = u.pn * BM + wc * 32 + 8 * fq;
        const float* xs = (u.pm * BM < msplit) ? xa : xb - (size_t)msplit * 1024;
#pragma unroll
        for (int ai = 0; ai < 2; ++ai)
#pragma unroll
            for (int m = 0; m < 4; ++m) { const size_t row = (size_t)(row0 + ai * HALF + m * 16); float ss = 0.f;
#pragma unroll
                for (int bj = 0; bj < 2; ++bj) { const size_t off = row * 1024 + col0 + bj * HALF;
                    const f32x4 x0 = *(const f32x4*)(xs + off), x1 = *(const f32x4*)(xs + off + 4);
                    const f32x4 v0 = acc[ai][bj][m][0] + x0, v1 = acc[ai][bj][m][1] + x1;
                    ss += (v0[0] * v0[0] + v0[1] * v0[1]) + (v0[2] * v0[2] + v0[3] * v0[3]) + (v1[0] * v1[0] + v1[1] * v1[1]) + (v1[2] * v1[2] + v1[3] * v1[3]);
                    *(u32x4*)(X1B + off) = pack8(v0, v1); }
                ss += __shfl_xor(ss, 16); ss += __shfl_xor(ss, 32);
                if (fq == 0) atomicAdd(SS + row, ss); }
    }
};
struct EpiY {
    static constexpr bool PERM = true, AFTER_DRAIN = false;
    const bf16_t* X1B; float* OUT; float* SS;
    __device__ __forceinline__ void operator()(f32x4 (&acc)[2][2][4][2], const Unit& u, int wr, int wc, int fr, int fq) const {
        const int row0 = u.pm * BM + wr * 64 + fr; const int col0 = u.pn * BM + wc * 32 + 8 * fq;
#pragma unroll
        for (int ai = 0; ai < 2; ++ai)
#pragma unroll
            for (int m = 0; m < 4; ++m) { const size_t row = (size_t)(row0 + ai * HALF + m * 16); float ss = 0.f;
#pragma unroll
                for (int bj = 0; bj < 2; ++bj) { const size_t off = row * 1024 + col0 + bj * HALF;
                    f32x4 x0, x1; unpack8(*(const u32x4*)(X1B + off), x0, x1);
                    const f32x4 v0 = acc[ai][bj][m][0] + x0, v1 = acc[ai][bj][m][1] + x1;
                    *(f32x4*)(OUT + off) = v0; *(f32x4*)(OUT + off + 4) = v1;
                    ss += (v0[0] * v0[0] + v0[1] * v0[1]) + (v0[2] * v0[2] + v0[3] * v0[3]) + (v1[0] * v1[0] + v1[1] * v1[1]) + (v1[2] * v1[2] + v1[3] * v1[3]); }
                ss += __shfl_xor(ss, 16); ss += __shfl_xor(ss, 32);
                if (fq == 0) atomicAdd(SS + row, ss); }
    }
};
struct EpiHid {
    static constexpr bool PERM = true, AFTER_DRAIN = false;
    bf16_t* HID; const float* SS; float eps;
    __device__ __forceinline__ void operator()(f32x4 (&acc)[2][2][4][2], const Unit& u, int wr, int wc, int fr, int fq) const {
        const int row0 = u.pm * BM + wr * 64 + fr; const int col0 = u.pn * BM + wc * 32 + 8 * fq;
#pragma unroll
        for (int ai = 0; ai < 2; ++ai)
#pragma unroll
            for (int m = 0; m < 4; ++m) { const size_t row = (size_t)(row0 + ai * HALF + m * 16);
                const float rs = __builtin_amdgcn_rsqf(SS[row] * (1.0f / 1024.0f) + eps);
#pragma unroll
                for (int bj = 0; bj < 2; ++bj) { f32x4 v0 = acc[ai][bj][m][0] * rs, v1 = acc[ai][bj][m][1] * rs;
#pragma unroll
                    for (int e = 0; e < 4; ++e) { const float a = fmaxf(v0[e], 0.f), b = fmaxf(v1[e], 0.f); v0[e] = a * a; v1[e] = b * b; }
                    *(u32x4*)(HID + row * 4096 + col0 + bj * HALF) = pack8(v0, v1); } }
    }
};

struct EpiFinal {
    static constexpr bool PERM = true, AFTER_DRAIN = false;
    const bf16_t* X1B; float* OUT; float* SS; unsigned* CNT; const float* gfin; float eps;
    __device__ __forceinline__ void operator()(f32x4 (&acc)[2][2][4][2], const Unit& u, int wr, int wc, int fr, int fq) const {
        const int row0 = u.pm * BM + wr * 64 + fr; const int col0 = u.pn * BM + wc * 32 + 8 * fq;
#pragma unroll
        for (int ai = 0; ai < 2; ++ai)
#pragma unroll
            for (int m = 0; m < 4; ++m) { const size_t row = (size_t)(row0 + ai * HALF + m * 16); float ss = 0.f;
#pragma unroll
                for (int bj = 0; bj < 2; ++bj) { const size_t off = row * 1024 + col0 + bj * HALF;
                    f32x4 x0, x1; unpack8(*(const u32x4*)(X1B + off), x0, x1);
                    const f32x4 v0 = acc[ai][bj][m][0] + x0, v1 = acc[ai][bj][m][1] + x1;
                    acc[ai][bj][m][0] = v0; acc[ai][bj][m][1] = v1;
                    ss += (v0[0] * v0[0] + v0[1] * v0[1]) + (v0[2] * v0[2] + v0[3] * v0[3]) + (v1[0] * v1[0] + v1[1] * v1[1]) + (v1[2] * v1[2] + v1[3] * v1[3]); }
                ss += __shfl_xor(ss, 16); ss += __shfl_xor(ss, 32);
                if (fq == 0) atomicAdd(SS + row, ss); }
        asm volatile("s_waitcnt vmcnt(0)" ::: "memory");
        unsigned* cnt = CNT + 64 * u.pm;
        if ((fr | fq) == 0) __hip_atomic_fetch_add(cnt, 1u, __ATOMIC_RELAXED, __HIP_MEMORY_SCOPE_AGENT);
        while (__hip_atomic_load(cnt, __ATOMIC_RELAXED, __HIP_MEMORY_SCOPE_AGENT) < 32u) __builtin_amdgcn_s_sleep(2);
        asm volatile("" ::: "memory");
        f32x4 gv[2][2];
#pragma unroll
        for (int bj = 0; bj < 2; ++bj)
#pragma unroll
            for (int n = 0; n < 2; ++n) gv[bj][n] = *(const f32x4*)(gfin + col0 + bj * HALF + 4 * n);
#pragma unroll
        for (int ai = 0; ai < 2; ++ai)
#pragma unroll
            for (int m = 0; m < 4; ++m) { const size_t row = (size_t)(row0 + ai * HALF + m * 16);
                const float rs = 1.0f / sqrtf(__hip_atomic_load(SS + row, __ATOMIC_RELAXED, __HIP_MEMORY_SCOPE_AGENT) * (1.0f / 1024.0f) + eps);
#pragma unroll
                for (int bj = 0; bj < 2; ++bj) { const size_t off = row * 1024 + col0 + bj * HALF;
                    *(f32x4*)(OUT + off) = acc[ai][bj][m][0] * rs * gv[bj][0]; *(f32x4*)(OUT + off + 4) = acc[ai][bj][m][1] * rs * gv[bj][1]; } }
    }
};
template <class Epi, class Sched, bool ALIGN_EPI = false, bool SP2 = false>
__device__ __forceinline__ void gemm_phase(PG8_LAS unsigned char* lds, const Gemm g, const Sched& S, const Epi& E) {
    const int tid = threadIdx.x, wid = __builtin_amdgcn_readfirstlane(tid >> 6), lane = tid & 63, wr = wid >> 2, wc = wid & 3, fr = lane & 15, fq = lane >> 4;
    const int K = g.K, nt = K / BK;
    unsigned voffA[2], voffB[2];
#pragma unroll
    for (int i = 0; i < 2; ++i) { int R, C; stage_rc(tid * 16 + i * 8192, R, C); const int Rb = Epi::PERM ? ((R & ~31) + perm32(R & 31)) : R;
        voffA[i] = (unsigned)(R * K + C) * 2u; voffB[i] = (unsigned)(Rb * K + C) * 2u; }
    const size_t kstep = (size_t)(BK * 2);
    const size_t hstep = (size_t)HALF * K * 2;
    const size_t tstep = 2 * hstep;
    const unsigned ldsw = (unsigned)wid * 1024u;
    const int aoff = lds_byte(wr * 64 + fr, fq * 8), boff = lds_byte(wc * 32 + fr, fq * 8);
#define PG8_SA(b, h) (((b) * 2 + (h)) * HTB)
#define PG8_SB(b, h) ((4 + (b) * 2 + (h)) * HTB)
#define PG8_STAGE(bufoff, gbase, voff) do { _Pragma("unroll") for (int _i = 0; _i < 2; ++_i) \
        __builtin_amdgcn_global_load_lds((const unsigned*)((const char*)(gbase) + (voff)[_i]), (PG8_LAS unsigned*)(lds + (bufoff) + ldsw + _i * 8192), 16, 0, 0); } while (0)
#define PG8_LDA(dst, b, h) do { _Pragma("unroll") for (int m = 0; m < 4; ++m) _Pragma("unroll") for (int k = 0; k < 2; ++k) dst[m][k] = *(const PG8_LAS bf16x8*)(lds + PG8_SA(b, h) + aoff + m * 2048 + k * 1024); } while (0)
#define PG8_LDB(dst, b, h) do { _Pragma("unroll") for (int n = 0; n < 2; ++n) _Pragma("unroll") for (int k = 0; k < 2; ++k) dst[n][k] = *(const PG8_LAS bf16x8*)(lds + PG8_SB(b, h) + boff + n * 2048 + k * 1024); } while (0)
#define PG8_MMA(ai, bj, At, Bt) do { __builtin_amdgcn_s_setprio(1); _Pragma("unroll") for (int m = 0; m < 4; ++m) _Pragma("unroll") for (int n = 0; n < 2; ++n) _Pragma("unroll") for (int k = 0; k < 2; ++k) \
        acc[ai][bj][m][n] = __builtin_amdgcn_mfma_f32_16x16x32_bf16(Bt[n][k], At[m][k], acc[ai][bj][m][n], 0, 0, 0); __builtin_amdgcn_s_setprio(0); } while (0)
#define PG8_WAIT_V(n) asm volatile("s_waitcnt vmcnt(" #n ")" ::: "memory")
#define PG8_WAIT_L(n) asm volatile("s_waitcnt lgkmcnt(" #n ")" ::: "memory")
#define PG8_BAR __builtin_amdgcn_s_barrier()
#define PG8_SCHED __builtin_amdgcn_sched_barrier(0)
    Unit cur, nxt; int ui = 0;
    if (!S.next(0, cur)) return;
    f32x4 acc[2][2][4][2];
#pragma unroll
    for (int a = 0; a < 2; ++a)
#pragma unroll
        for (int b = 0; b < 2; ++b)
#pragma unroll
            for (int m = 0; m < 4; ++m)
#pragma unroll
                for (int n = 0; n < 2; ++n) acc[a][b][m][n] = (f32x4){0.f, 0.f, 0.f, 0.f};
    bf16x8 At[4][2], B0[2][2], B1[2][2];
    const char* cA = (const char*)g.A + (size_t)cur.pm * tstep; const char* cB = (const char*)g.Bt + (size_t)cur.pn * tstep;
    S.a_ready(cur);
    if constexpr (SP2) {
        PG8_STAGE(PG8_SB(0, 0), cB, voffB); PG8_STAGE(PG8_SB(0, 1), cB + hstep, voffB); PG8_STAGE(PG8_SA(0, 0), cA, voffA); PG8_STAGE(PG8_SA(0, 1), cA + hstep, voffA);
        if (wr == 1) PG8_BAR;
        PG8_WAIT_V(2); PG8_BAR;
        PG8_STAGE(PG8_SB(1, 0), cB + kstep, voffB); PG8_STAGE(PG8_SA(1, 0), cA + kstep, voffA); PG8_STAGE(PG8_SB(1, 1), cB + hstep + kstep, voffB);
        PG8_WAIT_V(6); PG8_BAR;
    } else {
        PG8_STAGE(PG8_SB(0, 0), cB, voffB); PG8_STAGE(PG8_SA(0, 0), cA, voffA); PG8_STAGE(PG8_SB(0, 1), cB + hstep, voffB); PG8_STAGE(PG8_SA(0, 1), cA + hstep, voffA);
        if (wr == 1) PG8_BAR;
        PG8_WAIT_V(4); PG8_BAR;
        PG8_STAGE(PG8_SB(1, 0), cB + kstep, voffB); PG8_STAGE(PG8_SA(1, 0), cA + kstep, voffA); PG8_STAGE(PG8_SB(1, 1), cB + hstep + kstep, voffB);
        PG8_WAIT_V(6); PG8_BAR;
    }
    for (;;) {
        const bool has_next = S.next(ui + 1, nxt);
        const char* nA = has_next ? (const char*)g.A + (size_t)nxt.pm * tstep : cA; const char* nB = has_next ? (const char*)g.Bt + (size_t)nxt.pn * tstep : cB;
        for (int t = 0; t < nt; t += 2) {
            const bool last = (t == nt - 2);
            const char* a1 = cA + (size_t)(t + 1) * kstep;
            const char* a2 = last ? nA : cA + (size_t)(t + 2) * kstep; const char* b2 = last ? nB : cB + (size_t)(t + 2) * kstep;
            const char* a3 = a2 + kstep; const char* b3 = b2 + kstep;
            if (last && has_next) S.a_ready(nxt);
            if constexpr (SP2) {
            PG8_LDB(B0, 0, 0); PG8_LDB(B1, 0, 1); PG8_SCHED; PG8_LDA(At, 0, 0); PG8_STAGE(PG8_SA(1, 1), a1 + hstep, voffA);
            PG8_WAIT_V(8); PG8_WAIT_L(0); PG8_BAR; PG8_MMA(0, 0, At, B0); PG8_MMA(0, 1, At, B1); PG8_BAR; PG8_SCHED;
            PG8_LDA(At, 0, 1); PG8_STAGE(PG8_SB(0, 0), b2, voffB); PG8_STAGE(PG8_SB(0, 1), b2 + hstep, voffB); PG8_STAGE(PG8_SA(0, 0), a2, voffA);
            PG8_WAIT_V(8); PG8_WAIT_L(0); PG8_BAR; PG8_MMA(1, 0, At, B0); PG8_MMA(1, 1, At, B1); PG8_BAR; PG8_SCHED;
            PG8_LDB(B0, 1, 0); PG8_LDB(B1, 1, 1); PG8_SCHED; PG8_LDA(At, 1, 0); PG8_STAGE(PG8_SA(0, 1), a2 + hstep, voffA);
            PG8_WAIT_V(8); PG8_WAIT_L(0); PG8_BAR; PG8_MMA(0, 0, At, B0); PG8_MMA(0, 1, At, B1); PG8_BAR; PG8_SCHED;
            PG8_LDA(At, 1, 1); PG8_STAGE(PG8_SB(1, 0), b3, voffB); PG8_STAGE(PG8_SB(1, 1), b3 + hstep, voffB); PG8_STAGE(PG8_SA(1, 0), a3, voffA);
            PG8_WAIT_V(8); PG8_WAIT_L(0); PG8_BAR; PG8_MMA(1, 0, At, B0); PG8_MMA(1, 1, At, B1); PG8_BAR; PG8_SCHED;
            } else {
            PG8_LDB(B0, 0, 0); PG8_SCHED; PG8_LDA(At, 0, 0); PG8_STAGE(PG8_SA(1, 1), a1 + hstep, voffA);
            PG8_WAIT_L(8); PG8_BAR; PG8_WAIT_L(0); PG8_MMA(0, 0, At, B0); PG8_BAR; PG8_SCHED;
            PG8_LDB(B1, 0, 1); PG8_STAGE(PG8_SB(0, 0), b2, voffB);
            PG8_BAR; PG8_WAIT_L(0); PG8_MMA(0, 1, At, B1); PG8_BAR;
            PG8_LDA(At, 0, 1); PG8_STAGE(PG8_SA(0, 0), a2, voffA);
            PG8_BAR; PG8_WAIT_L(0); PG8_MMA(1, 0, At, B0); PG8_BAR; PG8_SCHED;
            PG8_STAGE(PG8_SB(0, 1), b2 + hstep, voffB);
            PG8_WAIT_V(6); PG8_BAR; PG8_MMA(1, 1, At, B1); PG8_BAR;
            PG8_LDB(B0, 1, 0); PG8_SCHED; PG8_LDA(At, 1, 0); PG8_STAGE(PG8_SA(0, 1), a2 + hstep, voffA);
            PG8_WAIT_L(8); PG8_BAR; PG8_WAIT_L(0); PG8_MMA(0, 0, At, B0); PG8_BAR; PG8_SCHED;
            PG8_LDB(B1, 1, 1); PG8_STAGE(PG8_SB(1, 0), b3, voffB);
            PG8_BAR; PG8_WAIT_L(0); PG8_MMA(0, 1, At, B1); PG8_BAR;
            PG8_LDA(At, 1, 1); PG8_STAGE(PG8_SA(1, 0), a3, voffA);
            PG8_BAR; PG8_WAIT_L(0); PG8_MMA(1, 0, At, B0); PG8_BAR; PG8_SCHED;
            PG8_STAGE(PG8_SB(1, 1), b3 + hstep, voffB);
            PG8_WAIT_V(6); PG8_BAR; PG8_MMA(1, 1, At, B1); PG8_BAR;
            }
        }
        if constexpr (ALIGN_EPI) { if (wr == 0) PG8_BAR; }
        if constexpr (!Epi::AFTER_DRAIN) { E(acc, cur, wr, wc, fr, fq); S.done(cur); }
        if (!has_next) break;
#pragma unroll
        for (int a = 0; a < 2; ++a)
#pragma unroll
            for (int b = 0; b < 2; ++b)
#pragma unroll
                for (int m = 0; m < 4; ++m)
#pragma unroll
                    for (int n = 0; n < 2; ++n) acc[a][b][m][n] = (f32x4){0.f, 0.f, 0.f, 0.f};
        cur = nxt; cA = nA; cB = nB; ++ui;
        if constexpr (ALIGN_EPI) { if (wr == 1) PG8_BAR; }
    }
    PG8_WAIT_V(0);
    if constexpr (!ALIGN_EPI) { if (wr == 0) PG8_BAR; }
    PG8_BAR;
    if constexpr (Epi::AFTER_DRAIN) { E.fused(acc, cur, wr, wc, fr, fq, lds, wid, lane); S.done(cur); }
#undef PG8_SA
#undef PG8_SB
#undef PG8_STAGE
#undef PG8_LDA
#undef PG8_LDB
#undef PG8_MMA
#undef PG8_WAIT_V
#undef PG8_WAIT_L
#undef PG8_BAR
#undef PG8_SCHED
}
}

constexpr int D = 1024, MP = 8 * 8192, MS = 8 * 2048, M = MP + MS, FF = 4096, NZ = 4096, PW = 512, NAW = 512;
constexpr float RMS_EPS = 1e-6f;
constexpr size_t MiB = 1u << 20;
constexpr size_t WS_WIN = 0, WS_WPP = 8 * MiB, WS_WNA = 9 * MiB, WS_WOUT = 10 * MiB, WS_WFF1 = 12 * MiB, WS_WFF2 = 20 * MiB;
constexpr size_t WS_SS1 = 28 * MiB, WS_SS2 = 29 * MiB, WS_CNT = 30 * MiB;
constexpr size_t WS_XN = 32 * MiB;
constexpr size_t WS_POOLED = WS_XN, WS_ATTN = WS_XN + (size_t)M * 512 * 2;
constexpr size_t WS_ZP = 192 * MiB;
constexpr size_t WS_QH = WS_ZP + (size_t)M * 512 * 2;
constexpr size_t WS_GT = 512 * MiB;
constexpr size_t WS_HID = WS_ZP;
constexpr size_t WS_END = 832 * MiB;
static_assert(WS_XN + (size_t)M * 1024 * 2 <= WS_ZP && WS_ZP + (size_t)M * 2048 * 2 <= WS_GT && WS_GT + (size_t)M * 2048 * 2 <= WS_END && WS_HID + (size_t)M * 4096 * 2 <= WS_END, "ws map");

constexpr int NWAVES = 8, LDS_BYTES = 147456;
#define LAS __attribute__((address_space(3)))
typedef unsigned short bf16;
typedef unsigned v4u __attribute__((ext_vector_type(4)));
typedef unsigned v2u __attribute__((ext_vector_type(2)));
typedef float f32x4 __attribute__((ext_vector_type(4)));
typedef short bf16x8 __attribute__((ext_vector_type(8)));
typedef short s16x4 __attribute__((ext_vector_type(4)));
#define LDS_WAIT() asm volatile("s_waitcnt lgkmcnt(0)" ::: "memory")
__device__ __forceinline__ unsigned f2bf(float f) { unsigned u = __builtin_bit_cast(unsigned, f); return (u + 0x7fffu + ((u >> 16) & 1u)) >> 16; }
__device__ __forceinline__ unsigned pk2(float lo, float hi) { return f2bf(lo) | (f2bf(hi) << 16); }
__device__ __forceinline__ float wave_sum(float v) {
#pragma unroll
    for (int o = 1; o < 64; o <<= 1) v += __shfl_xor(v, o);
    return v;
}

struct Args { const float* in[15]; float* out; unsigned char* ws; };

__device__ __forceinline__ void p0_transpose_item(const float* W, int K, int N, bf16* WT, LAS float* scr, int item, int lane, const float* kscale = nullptr) {
    const int nblk = N / 32, kb = item / nblk, nb = item % nblk, k0 = 64 * kb, n0 = 32 * nb;
#pragma unroll 8
    for (int i = 0; i < 32; ++i) { const int kk = 2 * i + (lane >> 5); scr[kk * 33 + (lane & 31)] = W[(size_t)(k0 + kk) * N + n0 + (lane & 31)] * (kscale ? kscale[k0 + kk] : 1.0f); }
    LDS_WAIT(); asm volatile("" ::: "memory");
    const int c = lane & 7;
#pragma unroll
    for (int j = 0; j < 4; ++j) { const int n = (lane >> 3) + 8 * j; const LAS float* s = scr + (8 * c) * 33 + n;
        v4u o; o.x = pk2(s[0 * 33], s[1 * 33]); o.y = pk2(s[2 * 33], s[3 * 33]); o.z = pk2(s[4 * 33], s[5 * 33]); o.w = pk2(s[6 * 33], s[7 * 33]);
        *(v4u*)(WT + (size_t)(n0 + n) * K + k0 + 8 * c) = o; }
    LDS_WAIT(); asm volatile("" ::: "memory");
}

__device__ __forceinline__ void p0_prologue(const Args& a, LAS unsigned char* lds, int gw, int NGW, int wave, int lane) {
    unsigned char* ws = a.ws;
    LAS float* scr = (LAS float*)(lds + wave * 16384);
    constexpr int I_IN = (D / 64) * (NZ / 32), I_NA = (NAW / 64) * (D / 32), I_OUT = (D / 64) * (D / 32), I_F1 = (D / 64) * (FF / 32), I_F2 = (FF / 64) * (D / 32);
    constexpr int NITEMS = I_IN + I_NA + I_OUT + I_F1 + I_F2;
    for (int it = gw; it < NITEMS; it += NGW) {
        int r = it;
        if (r < I_IN) { p0_transpose_item(a.in[3], D, NZ, (bf16*)(ws + WS_WIN), scr, r, lane); continue; } r -= I_IN;
        if (r < I_NA) { p0_transpose_item(a.in[9], NAW, D, (bf16*)(ws + WS_WNA), scr, r, lane); continue; } r -= I_NA;
        if (r < I_OUT) { p0_transpose_item(a.in[10], D, D, (bf16*)(ws + WS_WOUT), scr, r, lane); continue; } r -= I_OUT;
        if (r < I_F1) { p0_transpose_item(a.in[12], D, FF, (bf16*)(ws + WS_WFF1), scr, r, lane, a.in[11]); continue; } r -= I_F1;
        p0_transpose_item(a.in[13], FF, D, (bf16*)(ws + WS_WFF2), scr, r, lane);
    }
    {
        const float* wg = a.in[5]; const float* sc = a.in[6]; const float* wp = a.in[7]; bf16* WPP = (bf16*)(ws + WS_WPP);
        for (int it = NGW - 1 - gw; it < 64 * 16; it += NGW) {
            const int cc = it >> 4, nb = it & 15, g = cc >> 4, c0 = (cc & 15) * 8, n = nb * 64 + lane;
            float acc[8];
#pragma unroll
            for (int j = 0; j < 8; ++j) acc[j] = 0.f;
            for (int d = 0; d < 128; ++d) {
                const float pv = wp[(size_t)(g * 128 + d) * D + n] * sc[g * 128 + d];
#pragma unroll
                for (int j = 0; j < 8; ++j) acc[j] += wg[(size_t)(g * 128 + c0 + j) * 128 + d] * pv;
            }
            v4u o; o.x = pk2(acc[0], acc[1]); o.y = pk2(acc[2], acc[3]); o.z = pk2(acc[4], acc[5]); o.w = pk2(acc[6], acc[7]);
            *(v4u*)(WPP + (size_t)n * PW + g * 128 + c0) = o;
        }
    }
    {
        float* ss1 = (float*)(ws + WS_SS1); float* ss2 = (float*)(ws + WS_SS2);
        for (int i = gw * 64 + lane; i < M; i += NGW * 64) { ss1[i] = 0.f; ss2[i] = 0.f; }
        unsigned* cnt = (unsigned*)(ws + WS_CNT);
        for (int i = gw * 64 + lane; i < 320 * 64; i += NGW * 64) cnt[i] = 0u;
    }
    {
        const float* gm = a.in[2]; bf16* XN = (bf16*)(ws + WS_XN);
        f32x4 gv[4];
#pragma unroll
        for (int j = 0; j < 4; ++j) gv[j] = ((const f32x4*)gm)[lane + 64 * j];
        for (int m = gw; m < M; m += NGW) {
            const float* xrow = (m < MP) ? a.in[0] + (size_t)m * D : a.in[1] + (size_t)(m - MP) * D;
            const f32x4* xr = (const f32x4*)xrow + lane;
            f32x4 v[4]; float s = 0.f;
#pragma unroll
            for (int j = 0; j < 4; ++j) { v[j] = xr[64 * j]; s += (v[j].x * v[j].x + v[j].y * v[j].y) + (v[j].z * v[j].z + v[j].w * v[j].w); }
            const float rstd = 1.0f / sqrtf(wave_sum(s) * (1.f / D) + RMS_EPS);
            unsigned long long* o8 = (unsigned long long*)(XN + (size_t)m * D) + lane;
#pragma unroll
            for (int j = 0; j < 4; ++j) { const f32x4 w = v[j] * rstd * gv[j]; o8[64 * j] = (unsigned long long)pk2(w.x, w.y) | ((unsigned long long)pk2(w.z, w.w) << 32); }
        }
    }
}

template <int HW> __device__ __forceinline__ void pool_chunk(const bf16* PB, bf16* POOLED, int m0, int t0, int S, int ch) {
    constexpr int NR = 8 + 2 * HW;
    v4u w[NR];
#pragma unroll
    for (int k = 0; k < NR; ++k) { const int tt = t0 - HW + k; w[k] = (v4u){0u, 0u, 0u, 0u};
        if (tt >= 0 && tt < S) w[k] = *(const v4u*)(PB + (size_t)(m0 - HW + k) * PW + ch); }
    float s[8];
#pragma unroll
    for (int e = 0; e < 8; ++e) s[e] = 0.f;
#pragma unroll
    for (int k = 0; k < 2 * HW; ++k) { s[0] += pg8::bf_lo(w[k].x); s[1] += pg8::bf_hi(w[k].x); s[2] += pg8::bf_lo(w[k].y); s[3] += pg8::bf_hi(w[k].y);
        s[4] += pg8::bf_lo(w[k].z); s[5] += pg8::bf_hi(w[k].z); s[6] += pg8::bf_lo(w[k].w); s[7] += pg8::bf_hi(w[k].w); }
#pragma unroll
    for (int i = 0; i < 8; ++i) {
        const int t = t0 + i; const int lo = (t - HW > 0) ? t - HW : 0, hi = (t + HW < S) ? t + HW : S;
        const float inv = 1.0f / (float)(hi - lo);
        const v4u sf = w[i + HW];
        v4u o; o.x = pk2(s[0] * inv - pg8::bf_lo(sf.x), s[1] * inv - pg8::bf_hi(sf.x)); o.y = pk2(s[2] * inv - pg8::bf_lo(sf.y), s[3] * inv - pg8::bf_hi(sf.y));
        o.z = pk2(s[4] * inv - pg8::bf_lo(sf.z), s[5] * inv - pg8::bf_hi(sf.z)); o.w = pk2(s[6] * inv - pg8::bf_lo(sf.w), s[7] * inv - pg8::bf_hi(sf.w));
        *(v4u*)(POOLED + (size_t)(m0 + i) * PW + ch) = o;
        if (i < 7) { const v4u a = w[i + 2 * HW], b = w[i];
            s[0] += pg8::bf_lo(a.x) - pg8::bf_lo(b.x); s[1] += pg8::bf_hi(a.x) - pg8::bf_hi(b.x); s[2] += pg8::bf_lo(a.y) - pg8::bf_lo(b.y); s[3] += pg8::bf_hi(a.y) - pg8::bf_hi(b.y);
            s[4] += pg8::bf_lo(a.z) - pg8::bf_lo(b.z); s[5] += pg8::bf_hi(a.z) - pg8::bf_hi(b.z); s[6] += pg8::bf_lo(a.w) - pg8::bf_lo(b.w); s[7] += pg8::bf_hi(a.w) - pg8::bf_hi(b.w); }
    }
}
__device__ __forceinline__ void p2_pool(const bf16* PB, bf16* POOLED, int gw, int NGW, int lane) {
    constexpr int NCH = (M / 32) * 4;
    for (int it = gw; it < NCH; it += NGW) {
        const int c32 = it >> 2, gq = (it + (it >> 11)) & 3;
        const int m0 = c32 * 32 + (lane >> 4) * 8, ch = gq * 128 + (lane & 15) * 8;
        int t0, S; if (m0 < MP) { t0 = m0 & 8191; S = 8192; } else { t0 = (m0 - MP) & 2047; S = 2048; }
        if (gq == 0) pool_chunk<1>(PB, POOLED, m0, t0, S, ch);
        else if (gq == 1) pool_chunk<2>(PB, POOLED, m0, t0, S, ch);
        else if (gq == 2) pool_chunk<4>(PB, POOLED, m0, t0, S, ch);
        else pool_chunk<8>(PB, POOLED, m0, t0, S, ch);
    }
}

constexpr int VSTRIDE = 160;
constexpr int VBUF_BYTES = 32 * VSTRIDE;
constexpr int RPB_OFF = 8 * VBUF_BYTES;
__device__ __forceinline__ int na_rs(int r, int rows) { int rs = r - 4; rs = rs < 0 ? 0 : rs; return rs > rows - 8 ? rows - 8 : rs; }
__device__ __forceinline__ void p2_natten(const bf16* QH, const bf16* KH, const bf16* VH, bf16* ATTN, const float* rpb, LAS unsigned char* lds, int blk, int G, int tid, int wave, int lane) {
    LAS float* rp = (LAS float*)(lds + RPB_OFF);
    for (int i = tid; i < 8 * 15 * 31; i += NWAVES * 64) rp[i] = rpb[i] * 1.4426950408889634f;
    __syncthreads();
    const int h = wave, l15 = lane & 15, g = lane >> 4;
    LAS unsigned char* vs = lds + wave * VBUF_BYTES;
    const LAS float* rph = rp + h * 15 * 31;
    const bf16* Qh = QH + (size_t)h * M * 64; const bf16* Kh = KH + (size_t)h * M * 64; const bf16* Vh = VH + (size_t)h * M * 64;
    constexpr int NUNITS = 8 * 4 * 32 + 8 * 4 * 8;
    const int per = (NUNITS + G - 1) / G;
    const int u0 = blk * per, u1 = (u0 + per < NUNITS) ? u0 + per : NUNITS;
    const float C2 = 0.125f * 1.4426950408889634f;
    const LAS unsigned char* trp = vs + (4 * g + (l15 >> 2)) * VSTRIDE + 8 * (l15 & 3);
    for (int u = u0; u < u1; ++u) {
        int seqbase, n, r0, rows;
        if (u < 1024) { seqbase = (u >> 7) * 8192; const int rem = u & 127; n = rem >> 5; r0 = (rem & 31) * 4; rows = 128; }
        else { const int v = u - 1024; seqbase = MP + (v >> 5) * 2048; const int rem = v & 31; n = rem >> 3; r0 = (rem & 7) * 4; rows = 32; }
        int kcs = 16 * n - 8; kcs = kcs < 0 ? 0 : kcs; kcs = kcs > 32 ? 32 : kcs;
        const int qc = 16 * n + l15; int cs = qc - 8; cs = cs < 0 ? 0 : cs; cs = cs > 48 ? 48 : cs;
        int dci[8]; unsigned vmask = 0u;
#pragma unroll
        for (int e = 0; e < 8; ++e) { const int kc = kcs + (e >> 2) * 16 + 4 * g + (e & 3); int d = kc - qc + 15; d = d < 0 ? 0 : d; d = d > 30 ? 30 : d; dci[e] = d;
            if (kc >= cs && kc < cs + 16) vmask |= 1u << e; }
        bf16x8 qf[4][2];
#pragma unroll
        for (int j = 0; j < 4; ++j) { const bf16* qrow = Qh + (size_t)(seqbase + (r0 + j) * 64 + 16 * n + l15) * 64 + 8 * g; qf[j][0] = *(const bf16x8*)qrow; qf[j][1] = *(const bf16x8*)(qrow + 32); }
        f32x4 o[4][4]; float mrun[4], lrun[4];
#pragma unroll
        for (int j = 0; j < 4; ++j) { mrun[j] = -3.0e38f; lrun[j] = 0.f;
#pragma unroll
            for (int dt = 0; dt < 4; ++dt) o[j][dt] = (f32x4){0.f, 0.f, 0.f, 0.f}; }
        const int kr_lo = na_rs(r0, rows), kr_hi = na_rs(r0 + 3, rows) + 7;
        bf16x8 kn[2][2]; v4u vn[4];
        { const size_t tok0 = (size_t)(seqbase + kr_lo * 64 + kcs);
#pragma unroll
          for (int th = 0; th < 2; ++th) { const bf16* krow = Kh + (tok0 + th * 16 + l15) * 64 + 8 * g; kn[th][0] = *(const bf16x8*)krow; kn[th][1] = *(const bf16x8*)(krow + 32); }
#pragma unroll
          for (int it = 0; it < 4; ++it) vn[it] = *(const v4u*)(Vh + tok0 * 64 + (it * 64 + lane) * 8); }
        for (int kr = kr_lo; kr <= kr_hi; ++kr) {
            bf16x8 kf[2][2];
#pragma unroll
            for (int th = 0; th < 2; ++th) { kf[th][0] = kn[th][0]; kf[th][1] = kn[th][1]; }
#pragma unroll
            for (int it = 0; it < 4; ++it) { const int piece = it * 64 + lane; *(LAS v4u*)(vs + (piece >> 3) * VSTRIDE + (piece & 7) * 16) = vn[it]; }
            { const int krn = (kr < kr_hi) ? kr + 1 : kr; const size_t tok0 = (size_t)(seqbase + krn * 64 + kcs);
#pragma unroll
              for (int th = 0; th < 2; ++th) { const bf16* krow = Kh + (tok0 + th * 16 + l15) * 64 + 8 * g; kn[th][0] = *(const bf16x8*)krow; kn[th][1] = *(const bf16x8*)(krow + 32); }
#pragma unroll
              for (int it = 0; it < 4; ++it) vn[it] = *(const v4u*)(Vh + tok0 * 64 + (it * 64 + lane) * 8); }
            LDS_WAIT(); asm volatile("" ::: "memory");
            bf16x8 vf[4];
#pragma unroll
            for (int dt = 0; dt < 4; ++dt) {
                const s16x4 lo = __builtin_bit_cast(s16x4, __builtin_amdgcn_ds_read_tr16_b64_v4i16((LAS s16x4*)(trp + 32 * dt)));
                const s16x4 hi = __builtin_bit_cast(s16x4, __builtin_amdgcn_ds_read_tr16_b64_v4i16((LAS s16x4*)(trp + 32 * dt + 16 * VSTRIDE)));
                vf[dt] = (bf16x8){lo[0], lo[1], lo[2], lo[3], hi[0], hi[1], hi[2], hi[3]};
            }
            LDS_WAIT(); asm volatile("" ::: "memory");
#pragma unroll
            for (int j = 0; j < 4; ++j) {
                const int r = r0 + j, rsj = na_rs(r, rows);
                if (kr >= rsj && kr <= rsj + 7) {
                    f32x4 z = {0.f, 0.f, 0.f, 0.f};
                    f32x4 s0 = __builtin_amdgcn_mfma_f32_16x16x32_bf16(kf[0][0], qf[j][0], z, 0, 0, 0); s0 = __builtin_amdgcn_mfma_f32_16x16x32_bf16(kf[0][1], qf[j][1], s0, 0, 0, 0);
                    f32x4 s1 = __builtin_amdgcn_mfma_f32_16x16x32_bf16(kf[1][0], qf[j][0], z, 0, 0, 0); s1 = __builtin_amdgcn_mfma_f32_16x16x32_bf16(kf[1][1], qf[j][1], s1, 0, 0, 0);
                    const LAS float* brow = rph + (kr - r + 7) * 31;
                    float v[8]; float cmax = -3.0e38f;
#pragma unroll
                    for (int e = 0; e < 8; ++e) { const float sc = (e < 4 ? s0[e & 3] : s1[e & 3]) * C2 + brow[dci[e]]; v[e] = ((vmask >> e) & 1u) ? sc : -3.0e38f; cmax = fmaxf(cmax, v[e]); }
                    cmax = fmaxf(cmax, __shfl_xor(cmax, 16)); cmax = fmaxf(cmax, __shfl_xor(cmax, 32));
                    const float mnew = fmaxf(mrun[j], cmax), alpha = __builtin_amdgcn_exp2f(mrun[j] - mnew); mrun[j] = mnew;
                    float ps = 0.f;
#pragma unroll
                    for (int e = 0; e < 8; ++e) { v[e] = __builtin_amdgcn_exp2f(v[e] - mnew); ps += v[e]; }
                    lrun[j] = lrun[j] * alpha + ps;
                    const v4u pw = {pg8::cvt_pk_bf16(v[0], v[1]), pg8::cvt_pk_bf16(v[2], v[3]), pg8::cvt_pk_bf16(v[4], v[5]), pg8::cvt_pk_bf16(v[6], v[7])};
                    const bf16x8 pf = __builtin_bit_cast(bf16x8, pw);
#pragma unroll
                    for (int dt = 0; dt < 4; ++dt) o[j][dt] = __builtin_amdgcn_mfma_f32_16x16x32_bf16(vf[dt], pf, o[j][dt] * alpha, 0, 0, 0);
                }
            }
        }
#pragma unroll
        for (int j = 0; j < 4; ++j) {
            float l = lrun[j]; l += __shfl_xor(l, 16); l += __shfl_xor(l, 32);
            const float inv = 1.0f / l;
            bf16* orow = ATTN + (size_t)(seqbase + (r0 + j) * 64 + 16 * n + l15) * NAW + h * 64 + 4 * g;
#pragma unroll
            for (int dt = 0; dt < 4; ++dt) { v2u w; w.x = pg8::cvt_pk_bf16(o[j][dt][0] * inv, o[j][dt][1] * inv); w.y = pg8::cvt_pk_bf16(o[j][dt][2] * inv, o[j][dt][3] * inv); *(v2u*)(orow + 16 * dt) = w; }
        }
    }
}

__device__ __forceinline__ void p8_final(float* out, const float* SS2, const float* gf, int gw, int NGW, int lane) {
    f32x4 gv[4];
#pragma unroll
    for (int j = 0; j < 4; ++j) gv[j] = ((const f32x4*)gf)[lane + 64 * j];
    for (int m = gw; m < M; m += NGW) {
        const float rstd = 1.0f / sqrtf(SS2[m] * (1.f / D) + RMS_EPS);
        f32x4* yr = (f32x4*)(out + (size_t)m * D) + lane;
        f32x4 v[4];
#pragma unroll
        for (int j = 0; j < 4; ++j) v[j] = yr[64 * j];
#pragma unroll
        for (int j = 0; j < 4; ++j) yr[64 * j] = v[j] * rstd * gv[j];
    }
}

__global__ void __launch_bounds__(NWAVES * 64, 2) fwd_megakernel(Args args) {
    extern __shared__ __attribute__((aligned(16))) unsigned char lds_raw[];
    cg::grid_group grid = cg::this_grid();
    LAS unsigned char* lds = (LAS unsigned char*)lds_raw;
    const int tid = threadIdx.x, lane = tid & 63, wave = __builtin_amdgcn_readfirstlane(tid >> 6);
    const int G = gridDim.x, blk = blockIdx.x;
    const int gw = blk * NWAVES + wave, NGW = G * NWAVES;
    unsigned char* ws = args.ws;
    bf16* XN = (bf16*)(ws + WS_XN); bf16* ZP = (bf16*)(ws + WS_ZP); bf16* QH = (bf16*)(ws + WS_QH); bf16* GT = (bf16*)(ws + WS_GT);
    bf16* POOLED = (bf16*)(ws + WS_POOLED); bf16* ATTN = (bf16*)(ws + WS_ATTN); bf16* MIX = (bf16*)(ws + WS_ZP);
    bf16* X1G = (bf16*)(ws + WS_XN); bf16* HID = (bf16*)(ws + WS_HID);
    float* SS1 = (float*)(ws + WS_SS1); float* SS2 = (float*)(ws + WS_SS2);

    p0_prologue(args, lds, gw, NGW, wave, lane);
    grid.sync();
    { pg8::Gemm g{XN, (const bf16*)(ws + WS_WIN), M, NZ, D}; pg8::StaticOrder S; S.init(M, NZ, G, blk);
      pg8::EpiZ E{ZP, QH, GT, args.in[4]};
      pg8::gemm_phase<pg8::EpiZ, pg8::StaticOrder, true, true>(lds, g, S, E); }
    grid.sync();
    p2_pool(ZP, POOLED, gw, NGW, lane);
    p2_natten(QH, QH + (size_t)M * 512, QH + (size_t)M * 1024, ATTN, args.in[8], lds, blk, G, tid, wave, lane);
    grid.sync();
    { pg8::Gemm g{POOLED, (const bf16*)(ws + WS_WPP), 2 * M, 2 * D, PW}; pg8::PairOrder S; S.base.init(M, D, G, blk); S.dpm = M / 256; S.dpn = D / 256;
      pg8::EpiMix E{MIX, GT};
      pg8::gemm_phase<pg8::EpiMix, pg8::PairOrder, true, true>(lds, g, S, E); }
    grid.sync();
    { pg8::Gemm g{MIX, (const bf16*)(ws + WS_WOUT), M, D, D}; pg8::StaticOrder S; S.init(M, D, G, blk);
      pg8::EpiRes E{args.in[0], args.in[1], MP, X1G, SS1};
      pg8::gemm_phase<pg8::EpiRes, pg8::StaticOrder, true, true>(lds, g, S, E); }
    grid.sync();
    { pg8::Gemm g{X1G, (const bf16*)(ws + WS_WFF1), M, FF, D}; pg8::StaticOrder S; S.init(M, FF, G, blk);
      pg8::EpiHid E{HID, SS1, RMS_EPS};
      pg8::gemm_phase<pg8::EpiHid, pg8::StaticOrder, true, true>(lds, g, S, E); }
    grid.sync();
    if (G == 256) {
      pg8::Gemm g{HID, (const bf16*)(ws + WS_WFF2), M, D, FF}; pg8::StaticOrder S; S.init(M, D, G, blk);
      pg8::EpiFinal E{X1G, args.out, SS2, (unsigned*)(ws + WS_CNT), args.in[14], RMS_EPS};
      pg8::gemm_phase<pg8::EpiFinal, pg8::StaticOrder, true, true>(lds, g, S, E);
    } else {
      { pg8::Gemm g{HID, (const bf16*)(ws + WS_WFF2), M, D, FF}; pg8::StaticOrder S; S.init(M, D, G, blk);
        pg8::EpiY E{X1G, args.out, SS2};
        pg8::gemm_phase<pg8::EpiY, pg8::StaticOrder, true, true>(lds, g, S, E); }
      grid.sync();
      p8_final(args.out, SS2, args.in[14], gw, NGW, lane);
    }
}

extern "C" void kernel_launch(void* const* d_in, const int* in_sizes, int n_in, void* d_out, int out_size, void* d_ws, size_t ws_size, hipStream_t stream) {
    static int grid_blocks = 0;
    if (!grid_blocks) {
        if (n_in != 15 || out_size != M * D || ws_size < WS_END) { fprintf(stderr, "kernel_launch: unexpected shapes (n_in %d out %d ws %zu)\n", n_in, out_size, ws_size); grid_blocks = -1; return; }
        int dev = 0, cus = 0, per_cu = 0;
        (void)hipGetDevice(&dev);
        (void)hipDeviceGetAttribute(&cus, hipDeviceAttributeMultiprocessorCount, dev);
        (void)hipFuncSetAttribute((const void*)fwd_megakernel, hipFuncAttributeMaxDynamicSharedMemorySize, LDS_BYTES);
        (void)hipOccupancyMaxActiveBlocksPerMultiprocessor(&per_cu, (const void*)fwd_megakernel, NWAVES * 64, LDS_BYTES);
        if (per_cu < 1) per_cu = 1;
        grid_blocks = cus * per_cu;
    }
    if (grid_blocks < 0) return;
    Args a{};
    for (int i = 0; i < 15; ++i) a.in[i] = (const float*)d_in[i];
    a.out = (float*)d_out; a.ws = (unsigned char*)d_ws;
    void* kargs[] = {&a};
    hipError_t e = hipLaunchCooperativeKernel((const void*)fwd_megakernel, dim3(grid_blocks), dim3(NWAVES * 64), kargs, LDS_BYTES, stream);
    if (e != hipSuccess) fprintf(stderr, "cooperative launch failed: %s (grid %d)\n", hipGetErrorString(e), grid_blocks);
}
```
